# Optimizing an MI355X kernel written in HIP

```python
import jax, jax.numpy as jnp
from jax import lax
import numpy as np

D_MODEL = 1024
BATCH = 4
SEQ = 8192
DEPTH = 2

HEAD_DIM = 64
ROPE_THETA = 10000.0
GRID_W = 64
EPS = 1e-6
NEG_INF = -1e30

A_HEADS = 8
A_KV_HEADS = 2
A_BLOCK = 128

LRU_WIDTH = 512
LRU_BLOCKS = 8
LRU_BLOCK_W = LRU_WIDTH // LRU_BLOCKS
LRU_C = 8.0
CONV_W = 4
CONV_LEFT = 2

C_HEADS = 8
C_KV_HEADS = 2
C_HALF_WINDOW = 128
C_BLOCK = 128

D_PATTERNS = ((128, 1), (512, 4), (2048, 16))
D_GROUPS = 3
D_HEADS = 4
D_BLOCK = 64

N_BRANCH = 4
MLP_HIDDEN = 4 * D_MODEL

IN_SIZES = (
    A_HEADS * HEAD_DIM, A_KV_HEADS * HEAD_DIM, A_KV_HEADS * HEAD_DIM,
    LRU_WIDTH, LRU_WIDTH,
    C_HEADS * HEAD_DIM, C_KV_HEADS * HEAD_DIM, C_KV_HEADS * HEAD_DIM,
    D_GROUPS * D_HEADS * HEAD_DIM, D_GROUPS * D_HEADS * HEAD_DIM, D_GROUPS * D_HEADS * HEAD_DIM,
    N_BRANCH * D_MODEL,
)
N_IN = sum(IN_SIZES)

kernel_name = "hybrid_parallel_gated_encoder"


def rmsnorm(x, g):
    xf = x.astype(jnp.float32)
    y = xf * lax.rsqrt(jnp.mean(xf * xf, axis=-1, keepdims=True) + EPS) * g.astype(jnp.float32)
    return y.astype(x.dtype)


def rope_tables(pos, dim):
    inv = ROPE_THETA ** (-jnp.arange(0, dim, 2, dtype=jnp.float32) / dim)
    ang = pos.astype(jnp.float32)[:, None] * inv[None, :]
    return jnp.cos(ang), jnp.sin(ang)


def apply_rotary(x, cos, sin):
    half = x.shape[-1] // 2
    xf = x.astype(jnp.float32)
    x1, x2 = xf[..., :half], xf[..., half:]
    c, s = cos[:, None, :], sin[:, None, :]
    return jnp.concatenate([x1 * c - x2 * s, x2 * c + x1 * s], axis=-1).astype(x.dtype)


def axial_rotary(x, row_cs, col_cs):
    h = x.shape[-1] // 2
    return jnp.concatenate([apply_rotary(x[..., :h], *row_cs), apply_rotary(x[..., h:], *col_cs)], axis=-1)


def dense_block_attention(q, k, v, block):
    b, s, hk, g, hd = q.shape
    nb = s // block
    qb = jnp.moveaxis(q.reshape(b, nb, block, hk, g, hd), 1, 0)

    def one_block(qblk):
        sc = jnp.einsum('bqhgd,bkhd->bhgqk', qblk, k).astype(jnp.float32) * (hd ** -0.5)
        p = jax.nn.softmax(sc, axis=-1)
        return jnp.einsum('bhgqk,bkhd->bqhgd', p.astype(v.dtype), v)

    o = lax.map(one_block, qb)
    return jnp.moveaxis(o, 0, 1).reshape(b, s, hk * g * hd)


def banded_attention(q, k, v, half_window, block, sink=None):
    b, L, hk, g, hd = q.shape
    nb = -(-L // block)
    lp = nb * block
    nw = -(-half_window // block)
    q = jnp.pad(q, ((0, 0), (0, lp - L), (0, 0), (0, 0), (0, 0)))
    pad_k = ((0, 0), (nw * block, lp - L + nw * block), (0, 0), (0, 0))
    kb = jnp.pad(k, pad_k).reshape(b, nb + 2 * nw, block, hk, hd)
    vb = jnp.pad(v, pad_k).reshape(b, nb + 2 * nw, block, hk, hd)
    kw = jnp.concatenate([kb[:, j:j + nb] for j in range(2 * nw + 1)], axis=2)
    vw = jnp.concatenate([vb[:, j:j + nb] for j in range(2 * nw + 1)], axis=2)
    qb = q.reshape(b, nb, block, hk, g, hd)
    sc = jnp.einsum('bnqhgd,bnkhd->bnhgqk', qb, kw).astype(jnp.float32) * (hd ** -0.5)
    qpos = jnp.arange(nb)[:, None] * block + jnp.arange(block)[None, :]
    kpos = (jnp.arange(nb)[:, None] - nw) * block + jnp.arange((2 * nw + 1) * block)[None, :]
    rel = kpos[:, None, :] - qpos[:, :, None]
    valid = (jnp.abs(rel) <= half_window) & (kpos[:, None, :] >= 0) & (kpos[:, None, :] < L)
    sc = jnp.where(valid[None, :, None, None], sc, NEG_INF)
    m = jnp.max(sc, axis=-1)
    if sink is not None:
        sink_b = sink.astype(jnp.float32).reshape(hk, g)[None, None, :, :, None]
        m = jnp.maximum(m, sink_b)
    p = jnp.exp(sc - m[..., None])
    l = jnp.sum(p, axis=-1)
    if sink is not None:
        l = l + jnp.exp(sink_b - m)
    o = jnp.einsum('bnhgqk,bnkhd->bnqhgd', p.astype(v.dtype), vw).astype(jnp.float32)
    l_t = jnp.transpose(l, (0, 1, 4, 2, 3))
    lse = jnp.transpose(m, (0, 1, 4, 2, 3)) + jnp.log(l_t)
    o = (o / l_t[..., None]).reshape(b, lp, hk, g, hd)[:, :L].astype(v.dtype)
    return o, lse.reshape(b, lp, hk, g)[:, :L]


def mixer_a(q, k, v, qk_g, row_cs, col_cs):
    b, s = q.shape[:2]
    q = rmsnorm(q.reshape(b, s, A_HEADS, HEAD_DIM), qk_g[0])
    k = rmsnorm(k.reshape(b, s, A_KV_HEADS, HEAD_DIM), qk_g[1])
    v = v.reshape(b, s, A_KV_HEADS, HEAD_DIM)
    q = axial_rotary(q, row_cs, col_cs).reshape(b, s, A_KV_HEADS, A_HEADS // A_KV_HEADS, HEAD_DIM)
    k = axial_rotary(k, row_cs, col_cs)
    return dense_block_attention(q, k, v, A_BLOCK)


def rg_lru_scan(xc, gate_w, gate_b, lam, reverse):
    b, s, w = xc.shape
    xh = xc.reshape(b, s, LRU_BLOCKS, LRU_BLOCK_W)
    gl = jnp.einsum('bsnc,gncd->gbsnd', xh, gate_w.astype(jnp.float32)).reshape(2, b, s, w)
    gl = gl + gate_b.astype(jnp.float32)[:, None, None, :]
    r = jax.nn.sigmoid(gl[0])
    i = jax.nn.sigmoid(gl[1])
    log_a = -LRU_C * r * jax.nn.softplus(-lam.astype(jnp.float32))
    a = jnp.exp(log_a)
    u = jnp.sqrt(-jnp.expm1(2.0 * log_a)) * (i * xc)

    def combine(e1, e2):
        a1, b1 = e1
        a2, b2 = e2
        return a1 * a2, a2 * b1 + b2

    _, h = lax.associative_scan(combine, (a, u), axis=1, reverse=reverse)
    return h


def mixer_b(xb, yb, conv_w, conv_b, gate_w, gate_b, lam):
    s = xb.shape[1]
    xf = xb.astype(jnp.float32)
    xp = jnp.pad(xf, ((0, 0), (CONV_LEFT, CONV_W - 1 - CONV_LEFT), (0, 0)))
    xc = sum(xp[:, j:j + s] * conv_w[j].astype(jnp.float32) for j in range(CONV_W)) + conv_b.astype(jnp.float32)
    h = rg_lru_scan(xc, gate_w[0], gate_b[0], lam[0], False) + rg_lru_scan(xc, gate_w[1], gate_b[1], lam[1], True)
    return (h * jax.nn.gelu(yb.astype(jnp.float32))).astype(xb.dtype)


def mixer_c(q, k, v, sink, cs):
    b, s = q.shape[:2]
    q = apply_rotary(q.reshape(b, s, C_HEADS, HEAD_DIM), *cs).reshape(b, s, C_KV_HEADS, C_HEADS // C_KV_HEADS, HEAD_DIM)
    k = apply_rotary(k.reshape(b, s, C_KV_HEADS, HEAD_DIM), *cs)
    v = v.reshape(b, s, C_KV_HEADS, HEAD_DIM)
    o, _ = banded_attention(q, k, v, C_HALF_WINDOW, C_BLOCK, sink)
    return o.reshape(b, s, C_HEADS * HEAD_DIM)


def mixer_d(q, k, v, cs):
    b, s = q.shape[:2]
    n_h = D_GROUPS * D_HEADS
    q = apply_rotary(q.reshape(b, s, n_h, HEAD_DIM), *cs).reshape(b, s, D_GROUPS, D_HEADS, HEAD_DIM)
    k = apply_rotary(k.reshape(b, s, n_h, HEAD_DIM), *cs).reshape(b, s, D_GROUPS, D_HEADS, HEAD_DIM)
    v = v.reshape(b, s, D_GROUPS, D_HEADS, HEAD_DIM)
    outs, lses = [], []
    for gi, (window, dil) in enumerate(D_PATTERNS):
        L = s // dil

        def to_residue(t):
            t = t[:, :, gi].reshape(b, L, dil, D_HEADS, HEAD_DIM)
            return jnp.transpose(t, (0, 2, 1, 3, 4)).reshape(b * dil, L, D_HEADS, HEAD_DIM)

        o, lse = banded_attention(to_residue(q)[:, :, :, None, :], to_residue(k), to_residue(v),
                                  window // (2 * dil), D_BLOCK)
        o = jnp.transpose(o.reshape(b, dil, L, D_HEADS, HEAD_DIM), (0, 2, 1, 3, 4)).reshape(b, s, D_HEADS, HEAD_DIM)
        lse = jnp.transpose(lse.reshape(b, dil, L, D_HEADS), (0, 2, 1, 3)).reshape(b, s, D_HEADS)
        outs.append(o.astype(jnp.float32))
        lses.append(lse)
    wts = jax.nn.softmax(jnp.stack(lses, axis=0), axis=0)
    out = jnp.sum(wts[..., None] * jnp.stack(outs, axis=0), axis=0)
    return out.reshape(b, s, D_HEADS * HEAD_DIM).astype(q.dtype)


def setup_inputs(seed: int = 0) -> dict:
    key = jax.random.key(seed)
    ks = jax.random.split(key, 20)
    f32 = jnp.float32

    def nrm(k, shape, scale):
        return jax.random.normal(k, shape, f32) * scale

    a0 = jax.random.uniform(ks[9], (DEPTH, 2, LRU_WIDTH), f32, 0.9, 0.999)
    p = a0 ** (1.0 / LRU_C)
    lru_lambda = jnp.log(p) - jnp.log1p(-p)
    return {
        "x": nrm(ks[0], (BATCH, SEQ, D_MODEL), 1.0),
        "norm_mix_g": 1.0 + nrm(ks[1], (DEPTH, D_MODEL), 0.02),
        "w_in": nrm(ks[2], (DEPTH, D_MODEL, N_IN), D_MODEL ** -0.5),
        "gate_bias": nrm(ks[3], (DEPTH, N_BRANCH, D_MODEL), 0.02),
        "qk_norm_g": 1.0 + nrm(ks[4], (DEPTH, 2, HEAD_DIM), 0.02),
        "conv_w": nrm(ks[5], (DEPTH, CONV_W, LRU_WIDTH), CONV_W ** -0.5),
        "conv_b": nrm(ks[6], (DEPTH, LRU_WIDTH), 0.02),
        "lru_gate_w": nrm(ks[7], (DEPTH, 2, 2, LRU_BLOCKS, LRU_BLOCK_W, LRU_BLOCK_W), LRU_BLOCK_W ** -0.5),
        "lru_gate_b": nrm(ks[8], (DEPTH, 2, 2, LRU_WIDTH), 0.02),
        "lru_lambda": lru_lambda,
        "sink_logit": nrm(ks[10], (DEPTH, C_HEADS), 1.0),
        "w_proj_a": nrm(ks[11], (DEPTH, A_HEADS * HEAD_DIM, D_MODEL), (A_HEADS * HEAD_DIM) ** -0.5),
        "w_proj_b": nrm(ks[12], (DEPTH, LRU_WIDTH, D_MODEL), LRU_WIDTH ** -0.5),
        "w_proj_c": nrm(ks[13], (DEPTH, C_HEADS * HEAD_DIM, D_MODEL), (C_HEADS * HEAD_DIM) ** -0.5),
        "w_proj_d": nrm(ks[14], (DEPTH, D_HEADS * HEAD_DIM, D_MODEL), (D_HEADS * HEAD_DIM) ** -0.5),
        "w_out": nrm(ks[15], (DEPTH, D_MODEL, D_MODEL), D_MODEL ** -0.5),
        "norm_mlp_g": 1.0 + nrm(ks[16], (DEPTH, D_MODEL), 0.02),
        "w_mlp1": nrm(ks[17], (DEPTH, D_MODEL, MLP_HIDDEN), D_MODEL ** -0.5),
        "w_mlp2": nrm(ks[18], (DEPTH, MLP_HIDDEN, D_MODEL), MLP_HIDDEN ** -0.5),
        "norm_final_g": 1.0 + nrm(ks[19], (D_MODEL,), 0.02),
    }


def reference(x, norm_mix_g, w_in, gate_bias, qk_norm_g, conv_w, conv_b, lru_gate_w, lru_gate_b,
              lru_lambda, sink_logit, w_proj_a, w_proj_b, w_proj_c, w_proj_d, w_out, norm_mlp_g,
              w_mlp1, w_mlp2, norm_final_g):
    b, s, _ = x.shape
    rows = s // GRID_W
    pos = jnp.arange(s)
    row_pos = jnp.repeat(jnp.arange(rows), GRID_W)
    col_pos = jnp.tile(jnp.arange(GRID_W), rows)
    row_cs = rope_tables(row_pos, HEAD_DIM // 2)
    col_cs = rope_tables(col_pos, HEAD_DIM // 2)
    seq_cs = rope_tables(pos, HEAD_DIM)
    split_points = np.cumsum(IN_SIZES)[:-1]

    for l in range(DEPTH):
        hn = rmsnorm(x, norm_mix_g[l])
        proj = hn @ w_in[l]
        (aq, ak, av, bx, by, cq, ck, cv, dq, dk, dv, gl) = jnp.split(proj, split_points, axis=-1)
        ya = mixer_a(aq, ak, av, qk_norm_g[l], row_cs, col_cs)
        yb = mixer_b(bx, by, conv_w[l], conv_b[l], lru_gate_w[l], lru_gate_b[l], lru_lambda[l])
        yc = mixer_c(cq, ck, cv, sink_logit[l], seq_cs)
        yd = mixer_d(dq, dk, dv, seq_cs)
        gates = jax.nn.sigmoid((gl.reshape(b, s, N_BRANCH, D_MODEL) + gate_bias[l]).astype(jnp.float32)).astype(x.dtype)
        merged = (gates[:, :, 0] * (ya @ w_proj_a[l]) + gates[:, :, 1] * (yb @ w_proj_b[l])
                  + gates[:, :, 2] * (yc @ w_proj_c[l]) + gates[:, :, 3] * (yd @ w_proj_d[l]))
        x = x + merged @ w_out[l]
        hn = rmsnorm(x, norm_mlp_g[l])
        x = x + jnp.square(jax.nn.relu(hn @ w_mlp1[l])) @ w_mlp2[l]
    return rmsnorm(x, norm_final_g)
```

```cpp
#include <hip/hip_runtime.h>
#include <hip/hip_cooperative_groups.h>
#include <hip/hip_bf16.h>
#include <cstdio>
#include <cstdint>
#include <cmath>
namespace cg = cooperative_groups;
namespace pg8 {
#define PG8_LAS __attribute__((address_space(3)))
typedef unsigned short bf16_t;
typedef short bf16x8 __attribute__((ext_vector_type(8)));
typedef float f32x4 __attribute__((ext_vector_type(4)));
typedef unsigned u32x4 __attribute__((ext_vector_type(4)));
constexpr int BM = 256, BK = 64, HALF = 128, HTB = HALF * BK * 2  , STAGE_BYTES = 8 * HTB, NXCD = 8, WGM = 8;

__host__ __device__ __forceinline__ int lds_byte(int r, int c) { const int st = (r >> 4) * 2 + (c >> 5), rr = r & 15, cc = c & 31, ob = rr * 64 + cc * 2; return st * 1024 + (ob ^ (((ob >> 9) & 1) << 5)); }
__host__ __device__ __forceinline__ void stage_rc(int b, int& R, int& C) { const int st = b / 1024, sb = b % 1024, swz = sb ^ (((sb >> 9) & 1) << 5); R = (st >> 1) * 16 + swz / 64; C = (st & 1) * 32 + (swz % 64) / 2; }
__host__ __device__ __forceinline__ int perm32(int rho) { const int n = rho >> 4, i = rho & 15; return 8 * (i >> 2) + 4 * n + (i & 3); }

struct Unit { int pm, pn, br; };
struct Gemm { const bf16_t* A; const bf16_t* Bt; int M, N, K, lda, ldb; };

struct StaticOrder {
    int nM, nN, nwg, G, c;
    __host__ __device__ void init(int M, int N, int G_, int c_) { nM = M / BM; nN = N / BM; nwg = nM * nN; G = G_; c = c_; }
    __host__ __device__ bool next(int i, Unit& u) const {
        const long L = (long)i * G + c; if (L >= nwg) return false;
        int wgid = (int)L; { const int q = nwg / NXCD, r = nwg % NXCD, xcd = wgid % NXCD, off = wgid / NXCD; wgid = (xcd < r ? xcd * (q + 1) : r * (q + 1) + (xcd - r) * q) + off; }
        const int nig = WGM * nN, gid = wgid / nig, fm = gid * WGM, gsz = (nM - fm) < WGM ? (nM - fm) : WGM;
        u.pm = fm + ((wgid % nig) % gsz); u.pn = (wgid % nig) / gsz; u.br = 0; return true;
    }
    __device__ __forceinline__ void a_ready(const Unit&) const {}
    __device__ __forceinline__ void done(const Unit&) const {}
    __device__ __forceinline__ size_t aoff(const Unit&) const { return 0; }
    __device__ __forceinline__ size_t boff(const Unit&) const { return 0; }
    __device__ __forceinline__ int ntiles(const Unit&, int K) const { return K / BK; }
};
struct LruOrder : StaticOrder {
    __device__ __forceinline__ size_t aoff(const Unit& u) const { return (size_t)(u.pn & 3) * 256; }
};
struct BranchOrder : StaticOrder {
    unsigned a0, a1, a2, a3, b1, b2, b3;
    __host__ __device__ bool next(int i, Unit& u) const { const bool ok = StaticOrder::next(i >> 2, u); u.br = i & 3; return ok; }
    __device__ __forceinline__ size_t aoff(const Unit& u) const { return u.br == 0 ? a0 : u.br == 1 ? a1 : u.br == 2 ? a2 : a3; }
    __device__ __forceinline__ size_t boff(const Unit& u) const { return u.br == 0 ? 0u : u.br == 1 ? b1 : u.br == 2 ? b2 : b3; }
    __device__ __forceinline__ int ntiles(const Unit& u, int) const { return u.br == 3 ? 4 : 8; }
};

__device__ __forceinline__ unsigned cvt_pk_bf16(float lo, float hi) { unsigned r; asm volatile("v_cvt_pk_bf16_f32 %0, %1, %2" : "=v"(r) : "v"(lo), "v"(hi)); return r; }
typedef float f32x2 __attribute__((ext_vector_type(2)));
__device__ __forceinline__ float sigm(float x) { return __builtin_amdgcn_rcpf(1.f + __builtin_amdgcn_exp2f(-1.4426950408889634f * x)); }
__device__ __forceinline__ float sg2(float z2) { return __builtin_amdgcn_rcpf(1.f + __builtin_amdgcn_exp2f(z2)); }
__device__ __forceinline__ float bflo(unsigned w) { return __uint_as_float(w << 16); }
__device__ __forceinline__ float bfhi(unsigned w) { return __uint_as_float(w & 0xffff0000u); }
typedef unsigned u32x2 __attribute__((ext_vector_type(2)));
constexpr int NPROJ = 4864, NGATE = 4096, NGT0 = NPROJ / 256;

struct EpiProj {
    static constexpr bool PERM = true, AFTER_DRAIN = false, PREFETCH = false;
    bf16_t* P;
    __device__ __forceinline__ void operator()(const f32x4 (&acc)[2][2][4][2], const Unit& u, int wr, int wc, int fr, int fq) const {
        const int row0 = u.pm * BM + wr * 64 + fr; const int col0 = u.pn * BM + wc * 32 + 8 * fq;
#pragma unroll
        for (int ai = 0; ai < 2; ++ai)
#pragma unroll
            for (int m = 0; m < 4; ++m) { bf16_t* rowp = P + (size_t)(row0 + ai * HALF + m * 16) * NPROJ + col0;
#pragma unroll
                for (int bj = 0; bj < 2; ++bj) { const f32x4 v0 = acc[ai][bj][m][0], v1 = acc[ai][bj][m][1];
                    u32x4 w; w.x = cvt_pk_bf16(v0[0], v0[1]); w.y = cvt_pk_bf16(v0[2], v0[3]); w.z = cvt_pk_bf16(v1[0], v1[1]); w.w = cvt_pk_bf16(v1[2], v1[3]);
                    *(u32x4*)(rowp + bj * HALF) = w; } }
    }
};
struct EpiGate {
    static constexpr bool PERM = true, AFTER_DRAIN = false, PREFETCH = true;
    unsigned char* Gt; const float* gbias; const float* rs; float sc;
    __device__ __forceinline__ void prefetch(const Unit& u, int wr, int fr, float (&pre)[8]) const {
#pragma unroll
        for (int i = 0; i < 8; ++i) pre[i] = rs[u.pm * BM + wr * 64 + fr + (i >> 2) * HALF + (i & 3) * 16];
    }
    __device__ __forceinline__ void operator()(const f32x4 (&acc)[2][2][4][2], const Unit& u, int wr, int wc, int fr, int fq, const float (&pre)[8]) const {
        typedef int v4i_ __attribute__((ext_vector_type(4)));
        const int row0 = u.pm * BM + wr * 64 + fr; const int g0 = u.pn * BM + wc * 32 + 8 * fq;
        f32x4 bv[2][2];
#pragma unroll
        for (int bj = 0; bj < 2; ++bj)
#pragma unroll
            for (int n = 0; n < 2; ++n) bv[bj][n] = *(const f32x4*)(gbias + g0 + bj * HALF + 4 * n) * -1.4426950408889634f;
#pragma unroll
        for (int ai = 0; ai < 2; ++ai)
#pragma unroll
            for (int m = 0; m < 4; ++m) { unsigned char* rowp = Gt + (size_t)(row0 + ai * HALF + m * 16) * NGATE + g0; const float scr_ = pre[ai * 4 + m] * sc * -1.4426950408889634f;
#pragma unroll
                for (int bj = 0; bj < 2; ++bj) { const v4i_ i0 = __builtin_bit_cast(v4i_, acc[ai][bj][m][0]), i1 = __builtin_bit_cast(v4i_, acc[ai][bj][m][1]);
                    const f32x4 v0 = (f32x4){(float)i0[0], (float)i0[1], (float)i0[2], (float)i0[3]} * scr_ + bv[bj][0], v1 = (f32x4){(float)i1[0], (float)i1[1], (float)i1[2], (float)i1[3]} * scr_ + bv[bj][1];
                    u32x2 w;
                    w.x = (unsigned)(sg2(v0[0]) * 255.f + 0.5f) | ((unsigned)(sg2(v0[1]) * 255.f + 0.5f) << 8) | ((unsigned)(sg2(v0[2]) * 255.f + 0.5f) << 16) | ((unsigned)(sg2(v0[3]) * 255.f + 0.5f) << 24);
                    w.y = (unsigned)(sg2(v1[0]) * 255.f + 0.5f) | ((unsigned)(sg2(v1[1]) * 255.f + 0.5f) << 8) | ((unsigned)(sg2(v1[2]) * 255.f + 0.5f) << 16) | ((unsigned)(sg2(v1[3]) * 255.f + 0.5f) << 24);
                    *(u32x2*)(rowp + bj * HALF) = w; } }
    }
};

struct EpiLru {
    static constexpr bool PERM = false, AFTER_DRAIN = false, PREFETCH = false;
    const bf16_t* XC; bf16_t* LA; bf16_t* U; const float* gb; const float* sp8; int TH;
    __device__ __forceinline__ void operator()(const f32x4 (&acc)[2][2][4][2], const Unit& u, int wr, int wc, int fr, int fq) const {
        const int d = u.pn >> 2, cb = u.pn & 3; const int row0 = u.pm * BM + wr * 64 + fr;
#pragma unroll
        for (int n = 0; n < 2; ++n) { const int c0 = cb * 128 + wc * 32 + n * 16 + 4 * fq;
            const f32x4 br = *(const f32x4*)(gb + (d * 2 + 0) * 512 + c0), bi = *(const f32x4*)(gb + (d * 2 + 1) * 512 + c0), sp = *(const f32x4*)(sp8 + d * 512 + c0);
            u32x2 xws[2][4];
#pragma unroll
            for (int ai = 0; ai < 2; ++ai)
#pragma unroll
                for (int m = 0; m < 4; ++m) xws[ai][m] = *(const u32x2*)(XC + (size_t)(row0 + ai * HALF + m * 16) * 512 + c0);
#pragma unroll
            for (int ai = 0; ai < 2; ++ai)
#pragma unroll
                for (int m = 0; m < 4; ++m) { const size_t row = (size_t)(row0 + ai * HALF + m * 16);
                    const u32x2 xw = xws[ai][m];
                    const float xv[4] = {bflo(xw.x), bfhi(xw.x), bflo(xw.y), bfhi(xw.y)};
                    float la[4], uu[4];
#pragma unroll
                    for (int e = 0; e < 4; ++e) { const float r = sigm(acc[ai][0][m][n][e] + br[e]), ig = sigm(acc[ai][1][m][n][e] + bi[e]);
                        const float l = -sp[e] * r, y = 2.f * l; la[e] = l * 1.4426950408889634f;
                        const float ser = -y * (1.f + y * (0.5f + y * (0.16666667f + y * (0.041666668f + y * 0.0083333338f))));
                        const float dir = 1.f - __builtin_amdgcn_exp2f(y * 1.4426950408889634f);
                        uu[e] = __builtin_amdgcn_sqrtf(y > -0.25f ? ser : dir) * (ig * xv[e]); }
                    u32x2 w0, w1; w0.x = cvt_pk_bf16(la[0], la[1]); w0.y = cvt_pk_bf16(la[2], la[3]); w1.x = cvt_pk_bf16(uu[0], uu[1]); w1.y = cvt_pk_bf16(uu[2], uu[3]);
                    *(u32x2*)(LA + ((size_t)d * TH + row) * 512 + c0) = w0; *(u32x2*)(U + ((size_t)d * TH + row) * 512 + c0) = w1; } }
    }
};

template <bool FIRST> struct EpiBranchT {
    static constexpr bool PERM = true, AFTER_DRAIN = false, PREFETCH = false;
    const unsigned char* Gt; bf16_t* Mg;
    __device__ __forceinline__ void operator()(const f32x4 (&acc)[2][2][4][2], const Unit& u, int wr, int wc, int fr, int fq) const {
        const int row0 = u.pm * BM + wr * 64 + fr; const int col0 = u.pn * BM + wc * 32 + 8 * fq; const float k = 1.0f / 255.0f;
        u32x2 gqs[2][4][2];
#pragma unroll
        for (int ai = 0; ai < 2; ++ai)
#pragma unroll
            for (int m = 0; m < 4; ++m)
#pragma unroll
                for (int bj = 0; bj < 2; ++bj) gqs[ai][m][bj] = *(const u32x2*)(Gt + (size_t)(row0 + ai * HALF + m * 16) * NGATE + col0 + bj * HALF);
#pragma unroll
        for (int ai = 0; ai < 2; ++ai)
#pragma unroll
            for (int m = 0; m < 4; ++m) { const size_t row = (size_t)(row0 + ai * HALF + m * 16);
#pragma unroll
                for (int bj = 0; bj < 2; ++bj) { const int col = col0 + bj * HALF;
                    const u32x2 gq = gqs[ai][m][bj];
                    f32x4 v0 = acc[ai][bj][m][0], v1 = acc[ai][bj][m][1];
                    v0[0] *= (float)(gq.x & 255u) * k; v0[1] *= (float)((gq.x >> 8) & 255u) * k; v0[2] *= (float)((gq.x >> 16) & 255u) * k; v0[3] *= (float)(gq.x >> 24) * k;
                    v1[0] *= (float)(gq.y & 255u) * k; v1[1] *= (float)((gq.y >> 8) & 255u) * k; v1[2] *= (float)((gq.y >> 16) & 255u) * k; v1[3] *= (float)(gq.y >> 24) * k;
                    bf16_t* p = Mg + row * 1024 + col;
                    if (!FIRST) { const u32x4 o = *(const u32x4*)p;
                        v0[0] += bflo(o.x); v0[1] += bfhi(o.x); v0[2] += bflo(o.y); v0[3] += bfhi(o.y); v1[0] += bflo(o.z); v1[1] += bfhi(o.z); v1[2] += bflo(o.w); v1[3] += bfhi(o.w); }
                    u32x4 w; w.x = cvt_pk_bf16(v0[0], v0[1]); w.y = cvt_pk_bf16(v0[2], v0[3]); w.z = cvt_pk_bf16(v1[0], v1[1]); w.w = cvt_pk_bf16(v1[2], v1[3]);
                    *(u32x4*)p = w; }
                if (m & 1) asm volatile("" ::: "memory"); }
    }
};

struct EpiBranch {
    static constexpr bool PERM = true, AFTER_DRAIN = false, PREFETCH = false;
    const unsigned char* Gt; bf16_t* Mg;
    __device__ __forceinline__ void operator()(const f32x4 (&acc)[2][2][4][2], const Unit& u, int wr, int wc, int fr, int fq) const {
        if (u.br == 0) { EpiBranchT<true> e{Gt, Mg}; e(acc, u, wr, wc, fr, fq); } else { EpiBranchT<false> e{Gt + u.br * 1024, Mg}; e(acc, u, wr, wc, fr, fq); }
    }
};

struct EpiResid {
    static constexpr bool PERM = false, AFTER_DRAIN = false, PREFETCH = false;
    const float* base; float* out;
    __device__ __forceinline__ void operator()(const f32x4 (&acc)[2][2][4][2], const Unit& u, int wr, int wc, int fr, int fq) const {
        const int row0 = u.pm * BM + wr * 64 + fr; const int col0 = u.pn * BM + wc * 32 + 4 * fq;
#pragma unroll
        for (int ai = 0; ai < 2; ++ai)
#pragma unroll
            for (int m = 0; m < 4; ++m) { const size_t off = (size_t)(row0 + ai * HALF + m * 16) * 1024 + col0;
#pragma unroll
                for (int bj = 0; bj < 2; ++bj)
#pragma unroll
                    for (int n = 0; n < 2; ++n) { const size_t o = off + bj * HALF + n * 16; *(f32x4*)(out + o) = *(const f32x4*)(base + o) + acc[ai][bj][m][n]; } }
    }
};

struct EpiRelu2 {
    static constexpr bool PERM = true, AFTER_DRAIN = false, PREFETCH = false;
    bf16_t* H; int ldh;
    __device__ __forceinline__ void operator()(const f32x4 (&acc)[2][2][4][2], const Unit& u, int wr, int wc, int fr, int fq) const {
        const int row0 = u.pm * BM + wr * 64 + fr; const int col0 = u.pn * BM + wc * 32 + 8 * fq;
#pragma unroll
        for (int ai = 0; ai < 2; ++ai)
#pragma unroll
            for (int m = 0; m < 4; ++m) { bf16_t* rowp = H + (size_t)(row0 + ai * HALF + m * 16) * ldh + col0;
#pragma unroll
                for (int bj = 0; bj < 2; ++bj) { f32x4 v0 = acc[ai][bj][m][0], v1 = acc[ai][bj][m][1];
#pragma unroll
                    for (int e = 0; e < 4; ++e) { const float a = fmaxf(v0[e], 0.f), b = fmaxf(v1[e], 0.f); v0[e] = a * a; v1[e] = b * b; }
                    u32x4 w; w.x = cvt_pk_bf16(v0[0], v0[1]); w.y = cvt_pk_bf16(v0[2], v0[3]); w.z = cvt_pk_bf16(v1[0], v1[1]); w.w = cvt_pk_bf16(v1[2], v1[3]);
                    *(u32x4*)(rowp + bj * HALF) = w; } }
    }
};

struct EpiResidB {
    static constexpr bool PERM = true, AFTER_DRAIN = false, PREFETCH = false;
    const void* base; bf16_t* out; int base_f32;
    __device__ __forceinline__ void operator()(const f32x4 (&acc)[2][2][4][2], const Unit& u, int wr, int wc, int fr, int fq) const {
        const int row0 = u.pm * BM + wr * 64 + fr; const int col0 = u.pn * BM + wc * 32 + 8 * fq;
#pragma unroll
        for (int ai = 0; ai < 2; ++ai)
#pragma unroll
            for (int m = 0; m < 4; ++m) { const size_t off = (size_t)(row0 + ai * HALF + m * 16) * 1024 + col0;
#pragma unroll
                for (int bj = 0; bj < 2; ++bj) { const size_t o = off + bj * HALF; f32x4 v0 = acc[ai][bj][m][0], v1 = acc[ai][bj][m][1];
                    if (base_f32) { v0 += *(const f32x4*)((const float*)base + o); v1 += *(const f32x4*)((const float*)base + o + 4); }
                    else { const u32x4 b = *(const u32x4*)((const bf16_t*)base + o); v0[0] += bflo(b.x); v0[1] += bfhi(b.x); v0[2] += bflo(b.y); v0[3] += bfhi(b.y); v1[0] += bflo(b.z); v1[1] += bfhi(b.z); v1[2] += bflo(b.w); v1[3] += bfhi(b.w); }
                    u32x4 w; w.x = cvt_pk_bf16(v0[0], v0[1]); w.y = cvt_pk_bf16(v0[2], v0[3]); w.z = cvt_pk_bf16(v1[0], v1[1]); w.w = cvt_pk_bf16(v1[2], v1[3]);
                    *(u32x4*)(out + o) = w; } }
    }
};

struct EpiRelu2I8 {
    static constexpr bool PERM = true, AFTER_DRAIN = false, PREFETCH = true;
    bf16_t* H; int ldh; const float* rs; const unsigned* cm;
    __device__ __forceinline__ void prefetch(const Unit& u, int wr, int fr, float (&pre)[8]) const {
#pragma unroll
        for (int i = 0; i < 8; ++i) pre[i] = rs[u.pm * BM + wr * 64 + fr + (i >> 2) * HALF + (i & 3) * 16];
    }
    __device__ __forceinline__ void operator()(const f32x4 (&acc)[2][2][4][2], const Unit& u, int wr, int wc, int fr, int fq, const float (&pre)[8]) const {
        typedef int v4i_ __attribute__((ext_vector_type(4)));
        const int row0 = u.pm * BM + wr * 64 + fr; const int col0 = u.pn * BM + wc * 32 + 8 * fq;
        f32x4 cs[2][2];
#pragma unroll
        for (int bj = 0; bj < 2; ++bj)
#pragma unroll
            for (int n = 0; n < 2; ++n) { const u32x4 t = *(const u32x4*)(cm + col0 + bj * HALF + 4 * n); cs[bj][n] = (f32x4){__uint_as_float(t.x), __uint_as_float(t.y), __uint_as_float(t.z), __uint_as_float(t.w)} * (1.0f / 127.0f); }
#pragma unroll
        for (int ai = 0; ai < 2; ++ai)
#pragma unroll
            for (int m = 0; m < 4; ++m) { bf16_t* rowp = H + (size_t)(row0 + ai * HALF + m * 16) * ldh + col0; const float f = pre[ai * 4 + m];
#pragma unroll
                for (int bj = 0; bj < 2; ++bj) { const v4i_ i0 = __builtin_bit_cast(v4i_, acc[ai][bj][m][0]), i1 = __builtin_bit_cast(v4i_, acc[ai][bj][m][1]); f32x4 v0, v1;
#pragma unroll
                    for (int e = 0; e < 4; ++e) { const float a = fmaxf((float)i0[e], 0.f) * (f * cs[bj][0][e]), b = fmaxf((float)i1[e], 0.f) * (f * cs[bj][1][e]); v0[e] = a * a; v1[e] = b * b; }
                    u32x4 w; w.x = cvt_pk_bf16(v0[0], v0[1]); w.y = cvt_pk_bf16(v0[2], v0[3]); w.z = cvt_pk_bf16(v1[0], v1[1]); w.w = cvt_pk_bf16(v1[2], v1[3]);
                    *(u32x4*)(rowp + bj * HALF) = w; } }
    }
};
template <class Epi, class Sched, bool ALIGN_EPI = false, bool SP2 = false, bool I8 = false>
__device__ __forceinline__ void gemm_phase(PG8_LAS unsigned char* lds, const Gemm g, const Sched& S, const Epi& E) {
    int tid_ = threadIdx.x; asm volatile("" : "+v"(tid_));
    const int tid = tid_, wid = __builtin_amdgcn_readfirstlane(tid >> 6), lane = tid & 63, wr = wid >> 2, wc = wid & 3, fr = lane & 15, fq = lane >> 4;
    const int K = g.K; int nt = K / BK;
    unsigned voffA[2], voffB[2];
#pragma unroll
    for (int i = 0; i < 2; ++i) { int R, C; stage_rc(tid * 16 + i * 8192, R, C); const int Rb = Epi::PERM ? ((R & ~31) + perm32(R & 31)) : R;
        voffA[i] = (unsigned)(R * g.lda + C) * 2u; voffB[i] = (unsigned)(Rb * g.ldb + C) * 2u; }
    const size_t kstep = (size_t)(BK * 2);
    const size_t hstepA = (size_t)HALF * g.lda * 2, hstepB = (size_t)HALF * g.ldb * 2;
    const size_t tstepA = 2 * hstepA, tstepB = 2 * hstepB;
    const unsigned ldsw = (unsigned)wid * 1024u;
    const int aoff = lds_byte(wr * 64 + fr, fq * 8), boff = lds_byte(wc * 32 + fr, fq * 8);
#define PG8_SA(b, h) (((b) * 2 + (h)) * HTB)
#define PG8_SB(b, h) ((4 + (b) * 2 + (h)) * HTB)
#define PG8_STAGE(bufoff, gbase, voff) do { _Pragma("unroll") for (int _i = 0; _i < 2; ++_i) \
        __builtin_amdgcn_global_load_lds((const unsigned*)((const char*)(gbase) + (voff)[_i]), (PG8_LAS unsigned*)(lds + (bufoff) + ldsw + _i * 8192), 16, 0, 0); } while (0)
#define PG8_LDA(dst, b, h) do { _Pragma("unroll") for (int m = 0; m < 4; ++m) _Pragma("unroll") for (int k = 0; k < 2; ++k) dst[m][k] = *(const PG8_LAS bf16x8*)(lds + PG8_SA(b, h) + aoff + m * 2048 + k * 1024); } while (0)
#define PG8_LDB(dst, b, h) do { _Pragma("unroll") for (int n = 0; n < 2; ++n) _Pragma("unroll") for (int k = 0; k < 2; ++k) dst[n][k] = *(const PG8_LAS bf16x8*)(lds + PG8_SB(b, h) + boff + n * 2048 + k * 1024); } while (0)
#define PG8_MMA(ai, bj, At, Bt) do { __builtin_amdgcn_s_setprio(1); _Pragma("unroll") for (int m = 0; m < 4; ++m) _Pragma("unroll") for (int n = 0; n < 2; ++n) _Pragma("unroll") for (int k = 0; k < 2; ++k) { \
        if constexpr (I8) { typedef int v4i_ __attribute__((ext_vector_type(4))); \
            acc[ai][bj][m][n] = __builtin_bit_cast(f32x4, __builtin_amdgcn_mfma_i32_16x16x64_i8(__builtin_bit_cast(v4i_, Bt[n][k]), __builtin_bit_cast(v4i_, At[m][k]), __builtin_bit_cast(v4i_, acc[ai][bj][m][n]), 0, 0, 0)); } \
        else acc[ai][bj][m][n] = __builtin_amdgcn_mfma_f32_16x16x32_bf16(Bt[n][k], At[m][k], acc[ai][bj][m][n], 0, 0, 0); } \
        __builtin_amdgcn_s_setprio(0); } while (0)
#define PG8_WAIT_V(n) asm volatile("s_waitcnt vmcnt(" #n ")" ::: "memory")
#define PG8_WAIT_L(n) asm volatile("s_waitcnt lgkmcnt(" #n ")" ::: "memory")
#define PG8_BAR __builtin_amdgcn_s_barrier()
#define PG8_SCHED __builtin_amdgcn_sched_barrier(0)
    Unit cur, nxt; int ui = 0;
    if (!S.next(0, cur)) return;
    float epre[8];
    f32x4 acc[2][2][4][2];
#pragma unroll
    for (int a = 0; a < 2; ++a)
#pragma unroll
        for (int b = 0; b < 2; ++b)
#pragma unroll
            for (int m = 0; m < 4; ++m)
#pragma unroll
                for (int n = 0; n < 2; ++n) acc[a][b][m][n] = (f32x4){0.f, 0.f, 0.f, 0.f};
    bf16x8 At[4][2], B0[2][2], B1[2][2];
    const char* cA = (const char*)g.A + (size_t)cur.pm * tstepA + S.aoff(cur); const char* cB = (const char*)g.Bt + (size_t)cur.pn * tstepB + S.boff(cur); nt = S.ntiles(cur, K);
    S.a_ready(cur);
    if constexpr (SP2) {
        PG8_STAGE(PG8_SB(0, 0), cB, voffB); PG8_STAGE(PG8_SB(0, 1), cB + hstepB, voffB); PG8_STAGE(PG8_SA(0, 0), cA, voffA); PG8_STAGE(PG8_SA(0, 1), cA + hstepA, voffA);
        if (wr == 1) PG8_BAR;
        PG8_WAIT_V(2); PG8_BAR;
        PG8_STAGE(PG8_SB(1, 0), cB + kstep, voffB); PG8_STAGE(PG8_SA(1, 0), cA + kstep, voffA); PG8_STAGE(PG8_SB(1, 1), cB + hstepB + kstep, voffB);
        PG8_WAIT_V(6); PG8_BAR;
    } else {
        PG8_STAGE(PG8_SB(0, 0), cB, voffB); PG8_STAGE(PG8_SA(0, 0), cA, voffA); PG8_STAGE(PG8_SB(0, 1), cB + hstepB, voffB); PG8_STAGE(PG8_SA(0, 1), cA + hstepA, voffA);
        if (wr == 1) PG8_BAR;
        PG8_WAIT_V(4); PG8_BAR;
        PG8_STAGE(PG8_SB(1, 0), cB + kstep, voffB); PG8_STAGE(PG8_SA(1, 0), cA + kstep, voffA); PG8_STAGE(PG8_SB(1, 1), cB + hstepB + kstep, voffB);
        PG8_WAIT_V(6); PG8_BAR;
    }
    for (;;) {
        const bool has_next = S.next(ui + 1, nxt);
        const char* nA = has_next ? (const char*)g.A + (size_t)nxt.pm * tstepA + S.aoff(nxt) : cA; const char* nB = has_next ? (const char*)g.Bt + (size_t)nxt.pn * tstepB + S.boff(nxt) : cB;
        for (int t = 0; t < nt; t += 2) {
            const bool last = (t == nt - 2);
            const char* a1 = cA + (size_t)(t + 1) * kstep;
            const char* a2 = last ? nA : cA + (size_t)(t + 2) * kstep; const char* b2 = last ? nB : cB + (size_t)(t + 2) * kstep;
            const char* a3 = a2 + kstep; const char* b3 = b2 + kstep;
            if (last && has_next) S.a_ready(nxt);
            if constexpr (Epi::PREFETCH) { if (last) E.prefetch(cur, wr, fr, epre); }
            if constexpr (SP2) {
            PG8_LDB(B0, 0, 0); PG8_LDB(B1, 0, 1); PG8_SCHED; PG8_LDA(At, 0, 0); PG8_STAGE(PG8_SA(1, 1), a1 + hstepA, voffA);
            PG8_WAIT_V(8); PG8_WAIT_L(0); PG8_BAR; PG8_MMA(0, 0, At, B0); PG8_MMA(0, 1, At, B1); PG8_BAR; PG8_SCHED;
            PG8_LDA(At, 0, 1); PG8_STAGE(PG8_SB(0, 0), b2, voffB); PG8_STAGE(PG8_SB(0, 1), b2 + hstepB, voffB); PG8_STAGE(PG8_SA(0, 0), a2, voffA);
            PG8_WAIT_V(8); PG8_WAIT_L(0); PG8_BAR; PG8_MMA(1, 0, At, B0); PG8_MMA(1, 1, At, B1); PG8_BAR; PG8_SCHED;
            PG8_LDB(B0, 1, 0); PG8_LDB(B1, 1, 1); PG8_SCHED; PG8_LDA(At, 1, 0); PG8_STAGE(PG8_SA(0, 1), a2 + hstepA, voffA);
            PG8_WAIT_V(8); PG8_WAIT_L(0); PG8_BAR; PG8_MMA(0, 0, At, B0); PG8_MMA(0, 1, At, B1); PG8_BAR; PG8_SCHED;
            PG8_LDA(At, 1, 1); PG8_STAGE(PG8_SB(1, 0), b3, voffB); PG8_STAGE(PG8_SB(1, 1), b3 + hstepB, voffB); PG8_STAGE(PG8_SA(1, 0), a3, voffA);
            PG8_WAIT_V(8); PG8_WAIT_L(0); PG8_BAR; PG8_MMA(1, 0, At, B0); PG8_MMA(1, 1, At, B1); PG8_BAR; PG8_SCHED;
            } else {
            PG8_LDB(B0, 0, 0); PG8_SCHED; PG8_LDA(At, 0, 0); PG8_STAGE(PG8_SA(1, 1), a1 + hstepA, voffA);
            PG8_WAIT_L(8); PG8_BAR; PG8_WAIT_L(0); PG8_MMA(0, 0, At, B0); PG8_BAR; PG8_SCHED;
            PG8_LDB(B1, 0, 1); PG8_STAGE(PG8_SB(0, 0), b2, voffB);
            PG8_BAR; PG8_WAIT_L(0); PG8_MMA(0, 1, At, B1); PG8_BAR;
            PG8_LDA(At, 0, 1); PG8_STAGE(PG8_SA(0, 0), a2, voffA);
            PG8_BAR; PG8_WAIT_L(0); PG8_MMA(1, 0, At, B0); PG8_BAR; PG8_SCHED;
            PG8_STAGE(PG8_SB(0, 1), b2 + hstepB, voffB);
            PG8_WAIT_V(6); PG8_BAR; PG8_MMA(1, 1, At, B1); PG8_BAR;
            PG8_LDB(B0, 1, 0); PG8_SCHED; PG8_LDA(At, 1, 0); PG8_STAGE(PG8_SA(0, 1), a2 + hstepA, voffA);
            PG8_WAIT_L(8); PG8_BAR; PG8_WAIT_L(0); PG8_MMA(0, 0, At, B0); PG8_BAR; PG8_SCHED;
            PG8_LDB(B1, 1, 1); PG8_STAGE(PG8_SB(1, 0), b3, voffB);
            PG8_BAR; PG8_WAIT_L(0); PG8_MMA(0, 1, At, B1); PG8_BAR;
            PG8_LDA(At, 1, 1); PG8_STAGE(PG8_SA(1, 0), a3, voffA);
            PG8_BAR; PG8_WAIT_L(0); PG8_MMA(1, 0, At, B0); PG8_BAR; PG8_SCHED;
            PG8_STAGE(PG8_SB(1, 1), b3 + hstepB, voffB);
            PG8_WAIT_V(6); PG8_BAR; PG8_MMA(1, 1, At, B1); PG8_BAR;
            }
        }
        if constexpr (ALIGN_EPI) { if (wr == 0) PG8_BAR; }
        if constexpr (!Epi::AFTER_DRAIN) { if constexpr (Epi::PREFETCH) E(acc, cur, wr, wc, fr, fq, epre); else E(acc, cur, wr, wc, fr, fq); S.done(cur); }
        if (!has_next) break;
#pragma unroll
        for (int a = 0; a < 2; ++a)
#pragma unroll
            for (int b = 0; b < 2; ++b)
#pragma unroll
                for (int m = 0; m < 4; ++m)
#pragma unroll
                    for (int n = 0; n < 2; ++n) acc[a][b][m][n] = (f32x4){0.f, 0.f, 0.f, 0.f};
        cur = nxt; cA = nA; cB = nB; ++ui; nt = S.ntiles(cur, K);
        if constexpr (ALIGN_EPI) { if (wr == 1) PG8_BAR; }
    }
    PG8_WAIT_V(0);
    if constexpr (!ALIGN_EPI) { if (wr == 0) PG8_BAR; }
    PG8_BAR;
    if constexpr (Epi::AFTER_DRAIN) { E.fused(acc, cur, wr, wc, fr, fq, lds, wid, lane); S.done(cur); }
#undef PG8_SA
#undef PG8_SB
#undef PG8_STAGE
#undef PG8_LDA
#undef PG8_LDB
#undef PG8_MMA
#undef PG8_WAIT_V
#undef PG8_WAIT_L
#undef PG8_BAR
#undef PG8_SCHED
}
}
namespace attn_body {
using bf16=__hip_bfloat16;
using bf16x8=__attribute__((ext_vector_type(8)))short;
using s16x4=__attribute__((ext_vector_type(4)))short;
using f32x16=__attribute__((ext_vector_type(16)))float;
using u32x4=__attribute__((ext_vector_type(4)))unsigned;
constexpr int SEQ=8192,D=64,DM=4864;
constexpr int NW=8,QBLK=32,QB=QBLK*NW,KVBLK=64,NQB=SEQ/QB;
__device__ __forceinline__ int crow(int r,int hi){return (r&3)+8*(r>>2)+4*hi;}
#define SBAR() __builtin_amdgcn_sched_barrier(0)
#define ATTN_STORE16(p,v) (*(u32x4*)(p)=(v))
constexpr int NSLOT=3, SLOTB=8192;
constexpr int LDS_K=0, LDS_V=NSLOT*SLOTB, LDS_WS=2*NSLOT*SLOTB, LDS_OST=LDS_WS+NW*64*4, LDS_BYTES=LDS_OST+NW*4096;
constexpr float C2=0.125f*1.4426950408889634f;
__device__ __forceinline__ void glds16(const void*gsrc,unsigned lds_dst){unsigned keep;
  asm volatile("s_mov_b32 %0, m0\n\ts_mov_b32 m0, %2\n\ts_nop 0\n\tglobal_load_lds_dwordx4 %1, off\n\ts_mov_b32 m0, %0":"=&s"(keep):"v"(gsrc),"s"(lds_dst):"memory");}
__device__ __forceinline__ float max3f(float a,float b,float c){float r;asm("v_max3_f32 %0, %1, %2, %3":"=v"(r):"v"(a),"v"(b),"v"(c));return r;}
__device__ __forceinline__ float max2f(float a,float b){float r;asm("v_max_f32_e32 %0, %1, %2":"=v"(r):"v"(a),"v"(b));return r;}
__device__ __forceinline__ float fadd_s(float a,float b){float r;asm("v_add_f32_e32 %0, %1, %2":"=v"(r):"v"(a),"v"(b));return r;}
__device__ __forceinline__ float fsub_s(float a,float b){float r;asm("v_sub_f32_e32 %0, %1, %2":"=v"(r):"v"(a),"v"(b));return r;}
typedef float f32x2_t __attribute__((ext_vector_type(2))); typedef __bf16 bf16x2_t __attribute__((ext_vector_type(2)));
__device__ __forceinline__ unsigned cvtpk_s(float lo,float hi){f32x2_t v={lo,hi};bf16x2_t b=__builtin_convertvector(v,bf16x2_t);return __builtin_bit_cast(unsigned,b);}
#define WAIT_BAR(N) asm volatile("s_waitcnt vmcnt(" #N ") lgkmcnt(0)\n\ts_barrier":::"memory")

__device__ __forceinline__ void qkt(f32x16&p0,f32x16&p1,const char*Kslot,const bf16x8*qr,const f32x16&negm,int r32,int hi){
  const char*kb=Kslot+hi*1024+r32*16;
  #pragma unroll
  for(int d0=0;d0<4;++d0){
    const bf16x8 b0=*reinterpret_cast<const bf16x8*>(kb+d0*2048);
    const bf16x8 b1=*reinterpret_cast<const bf16x8*>(kb+d0*2048+512);
    if(d0==0){p0=__builtin_amdgcn_mfma_f32_32x32x16_bf16(b0,qr[0],negm,0,0,0);p1=__builtin_amdgcn_mfma_f32_32x32x16_bf16(b1,qr[0],negm,0,0,0);}
    else{p0=__builtin_amdgcn_mfma_f32_32x32x16_bf16(b0,qr[d0],p0,0,0,0);p1=__builtin_amdgcn_mfma_f32_32x32x16_bf16(b1,qr[d0],p1,0,0,0);}}
}
typedef __attribute__((address_space(3))) const char* lds_cptr;
typedef short v4i16_t __attribute__((ext_vector_type(4)));
__device__ __forceinline__ void kload8(bf16x8*kf,lds_cptr kp){
  kf[0]=*(const __attribute__((address_space(3))) bf16x8*)(kp);      kf[1]=*(const __attribute__((address_space(3))) bf16x8*)(kp+512);
  kf[2]=*(const __attribute__((address_space(3))) bf16x8*)(kp+2048); kf[3]=*(const __attribute__((address_space(3))) bf16x8*)(kp+2560);
  kf[4]=*(const __attribute__((address_space(3))) bf16x8*)(kp+4096); kf[5]=*(const __attribute__((address_space(3))) bf16x8*)(kp+4608);
  kf[6]=*(const __attribute__((address_space(3))) bf16x8*)(kp+6144); kf[7]=*(const __attribute__((address_space(3))) bf16x8*)(kp+6656);
}
__device__ __forceinline__ void kload2(bf16x8*kf,lds_cptr kp,int j){ kf[2*j]=*(const __attribute__((address_space(3))) bf16x8*)(kp+j*2048); kf[2*j+1]=*(const __attribute__((address_space(3))) bf16x8*)(kp+j*2048+512); }
__device__ __forceinline__ s16x4 vtr(lds_cptr p){ return __builtin_bit_cast(s16x4,__builtin_amdgcn_ds_read_tr16_b64_v4i16((__attribute__((address_space(3))) v4i16_t*)p)); }
__device__ __forceinline__ float rowmax(const f32x16&p0,const f32x16&p1){
  float a=max3f(p0[0],p0[1],p1[0]),b=max3f(p0[2],p0[3],p1[1]);a=max3f(a,p1[2],p1[3]);
  #pragma unroll
  for(int r=4;r<16;r+=4){a=max3f(a,p0[r],p0[r+1]);b=max3f(b,p0[r+2],p0[r+3]);a=max3f(a,p1[r],p1[r+1]);b=max3f(b,p1[r+2],p1[r+3]);}
  const float m=max2f(a,b);
  auto rr=__builtin_amdgcn_permlane32_swap(__float_as_uint(m),__float_as_uint(m),false,false);
  return max2f(__uint_as_float(rr[0]),__uint_as_float(rr[1]));
}
__device__ __forceinline__ void pv(f32x16*o,int vb,bf16x8 pa0,bf16x8 pa1,bf16x8 pa2,bf16x8 pa3){
  #pragma unroll
  for(int d0=0;d0<2;++d0){s16x4 lo[4],hi[4];
    #pragma unroll
    for(int ks=0;ks<4;++ks){
      asm volatile("ds_read_b64_tr_b16 %0,%1 offset:%c2":"=&v"(lo[ks]):"v"(vb),"i"(d0*4096+ks*1024):"memory");
      asm volatile("ds_read_b64_tr_b16 %0,%1 offset:%c2":"=&v"(hi[ks]):"v"(vb),"i"(d0*4096+ks*1024+512):"memory");}
    asm volatile("s_waitcnt lgkmcnt(0)":::"memory");SBAR();
    #define PK(k) (bf16x8){lo[k][0],lo[k][1],lo[k][2],lo[k][3],hi[k][0],hi[k][1],hi[k][2],hi[k][3]}
    o[d0]=__builtin_amdgcn_mfma_f32_32x32x16_bf16(pa0,PK(0),o[d0],0,0,0);
    o[d0]=__builtin_amdgcn_mfma_f32_32x32x16_bf16(pa1,PK(1),o[d0],0,0,0);
    o[d0]=__builtin_amdgcn_mfma_f32_32x32x16_bf16(pa2,PK(2),o[d0],0,0,0);
    o[d0]=__builtin_amdgcn_mfma_f32_32x32x16_bf16(pa3,PK(3),o[d0],0,0,0);
    #undef PK
  }
}
template<int THRL> __device__ __forceinline__ void attn_unit(int qb,const bf16*Qh,const bf16*Kh,const bf16*Vh,bf16*Oh,char*shm,float mbound){
  int tid_=threadIdx.x; asm volatile("":"+v"(tid_));
  const int tid=tid_,lane=tid&63,r32=lane&31,hi=lane>>5; const int wid=__builtin_amdgcn_readfirstlane(tid>>6);
  const int q0=qb*QB;
  if(wid>=4) __builtin_amdgcn_s_setprio(1);
  const bf16*Qw=Qh+(long)(q0+wid*QBLK)*DM;
  const unsigned lds0=(unsigned)(uintptr_t)shm;
  float*wsf=(float*)(shm+LDS_WS)+wid*64;
  const bf16*ksrc=Kh+(long)lane*DM+wid*8;
  const bf16*vsrc=Vh+(long)(16*(wid&3)+(lane>>2))*DM+(wid>>2)*32+(lane&3)*8;
  const unsigned kdst=lds0+LDS_K+wid*1024, vdst=lds0+LDS_V+wid*1024;
  #define DMA_K(t,slot) glds16(ksrc+(long)(t)*KVBLK*DM,(unsigned)__builtin_amdgcn_readfirstlane(kdst+(slot)))
  #define DMA_V(t,slot) glds16(vsrc+(long)(t)*KVBLK*DM,(unsigned)__builtin_amdgcn_readfirstlane(vdst+(slot)))
  const int vb0=(int)(lds0+LDS_V)+((lane>>4)&1)*32+(lane&3)*8+(4*hi+((lane&15)>>2))*64;
  const char*Kbase=shm+LDS_K; bf16x8 kf[8];
  const lds_cptr shm3=(lds_cptr)shm; const lds_cptr kp0=shm3+LDS_K+hi*1024+r32*16; const lds_cptr vp0=shm3+LDS_V+((lane>>4)&1)*32+(lane&3)*8+(4*hi+((lane&15)>>2))*64;
  const int NT=SEQ/KVBLK;
  DMA_K(0,0);DMA_V(0,0);DMA_K(1,SLOTB);
  bf16x8 qr[4];
  #pragma unroll
  for(int d0=0;d0<4;++d0)qr[d0]=*reinterpret_cast<const bf16x8*>(&Qw[(long)r32*DM+d0*16+hi*8]);
  float l_reg=0.f;f32x16 o[2];o[0]=f32x16{};o[1]=f32x16{};f32x16 negm;
  _Pragma("unroll") for(int r=0;r<16;++r)negm[r]=-mbound; asm volatile("":"+v"(negm));
  const int qrel=wid*QBLK+r32;
  #define CMASK(P0,P1,t) do{}while(0)
  bool resc=false;
  #define START(P0,P1) do{ _Pragma("unroll") for(int r=0;r<16;++r)P0[r]=__builtin_amdgcn_exp2f(P0[r]); }while(0)
  #define RESC() do{ if(resc){ asm volatile("s_waitcnt lgkmcnt(0)":::"memory"); \
      _Pragma("unroll") for(int d_=0;d_<2;++d_) _Pragma("unroll") for(int r=0;r<16;++r)o[d_][r]*=wsf[crow(r,hi)]; } }while(0)
  f32x16 pA0,pA1,pB0,pB1;
  int sl_prev=0,sl_cur=0,sl_next=SLOTB;
  #define ROT() do{sl_prev=sl_cur;sl_cur=sl_next;sl_next=(sl_next==(NSLOT-1)*SLOTB)?0:sl_next+SLOTB;}while(0)
  DMA_K(2,2*SLOTB);
  WAIT_BAR(3);
  qkt(pA0,pA1,Kbase,qr,negm,r32,hi);asm volatile("s_nop 15\n\ts_nop 7":"+v"(pA0),"+v"(pA1));CMASK(pA0,pA1,0);
  START(pA0,pA1);
  _Pragma("unroll") for(int r=0;r<16;++r)pA1[r]=__builtin_amdgcn_exp2f(pA1[r]);
  WAIT_BAR(0);
  DMA_K(3,0);DMA_V(1,SLOTB);
  ROT();
  kload8(kf,kp0+sl_cur);
  WAIT_BAR(2);
  s16x4 vlo[8],vhi[8]; u32x4 pw0,pw1,pw2,pw3;
  #define PKW(P,B) cvtpk_s(P[B],P[B+1])
  #define PAF(k) __builtin_bit_cast(bf16x8,pw##k)
  #define VFR(i) (bf16x8){vlo[i][0],vlo[i][1],vlo[i][2],vlo[i][3],vhi[i][0],vhi[i][1],vhi[i][2],vhi[i][3]}
  #define PIN(x) asm volatile("":"+v"(x))
  #define MX3(a,b,c) __builtin_fmaxf(__builtin_fmaxf((a),(b)),(c))
  #define GAPA(MF,A0,A1,A2,A3,W0,W1,PW) do{ MF; sacc+=A0; sacc+=A1; sacc+=A2; sacc+=A3; PIN(sacc); W0; W1; PIN(PW); SBAR(); }while(0)
  #define EX(v) __builtin_amdgcn_exp2f(v)
  #define GAPB(MF,X,B) do{ MF; X[B]=EX(X[B]); X[B+1]=EX(X[B+1]); X[B+2]=EX(X[B+2]); X[B+3]=EX(X[B+3]); PIN(X); SBAR(); }while(0)
  #define VRD(i) do{ vlo[i]=vtr(vp_+(((i)>>2)*4096+((i)&3)*1024)); vhi[i]=vtr(vp_+(((i)>>2)*4096+((i)&3)*1024+512)); }while(0)
  #define KRD(G,j) do{ if(G){ kload2(kf,kp0+sl_next,j); SBAR(); } }while(0)
  #define STEP(C0,C1,P0,P1,t,GK,GV,GL) do{ SBAR(); \
    const lds_cptr vp_=vp0+sl_prev; \
    VRD(0); SBAR(); float sacc=(P0[0]+P0[1]); \
    GAPA(C0=__builtin_amdgcn_mfma_f32_32x32x16_bf16(kf[0],qr[0],negm,0,0,0), P0[2],P0[3],P0[4],P0[5],     pw0[0]=PKW(P0,0), pw0[1]=PKW(P0,2), pw0); \
    VRD(4); SBAR(); GAPA(C1=__builtin_amdgcn_mfma_f32_32x32x16_bf16(kf[1],qr[0],negm,0,0,0), P0[6],P0[7],P0[8],P0[9],     pw0[2]=PKW(P0,4), pw0[3]=PKW(P0,6), pw0); \
    VRD(1); SBAR(); GAPA(C0=__builtin_amdgcn_mfma_f32_32x32x16_bf16(kf[2],qr[1],C0,0,0,0),   P0[10],P0[11],P0[12],P0[13], pw1[0]=PKW(P0,8), pw1[1]=PKW(P0,10), pw1); \
    VRD(5); SBAR(); GAPA(C1=__builtin_amdgcn_mfma_f32_32x32x16_bf16(kf[3],qr[1],C1,0,0,0),   P0[14],P0[15],P1[0],P1[1],   pw1[2]=PKW(P0,12),pw1[3]=PKW(P0,14), pw1); \
    VRD(2); SBAR(); GAPA(C0=__builtin_amdgcn_mfma_f32_32x32x16_bf16(kf[4],qr[2],C0,0,0,0),   P1[2],P1[3],P1[4],P1[5],     pw2[0]=PKW(P1,0), pw2[1]=PKW(P1,2), pw2); \
    VRD(6); SBAR(); GAPA(C1=__builtin_amdgcn_mfma_f32_32x32x16_bf16(kf[5],qr[2],C1,0,0,0),   P1[6],P1[7],P1[8],P1[9],     pw2[2]=PKW(P1,4), pw2[3]=PKW(P1,6), pw2); \
    VRD(3); SBAR(); GAPA(C0=__builtin_amdgcn_mfma_f32_32x32x16_bf16(kf[6],qr[3],C0,0,0,0),   P1[10],P1[11],P1[12],P1[13], pw3[0]=PKW(P1,8), pw3[1]=PKW(P1,10), pw3); \
    VRD(7); SBAR(); GAPA(C1=__builtin_amdgcn_mfma_f32_32x32x16_bf16(kf[7],qr[3],C1,0,0,0),   P1[14],P1[15],0.f,0.f,       pw3[2]=PKW(P1,12),pw3[3]=PKW(P1,14), pw3); \
    l_reg+=sacc; \
    if(GK){DMA_K((t)+3,sl_cur);} if(GV){DMA_V((t)+1,sl_next);} \
    CMASK(C0,C1,t); \
    SBAR(); \
    GAPB(o[0]=__builtin_amdgcn_mfma_f32_32x32x16_bf16(PAF(0),VFR(0),o[0],0,0,0), C0,0); \
    GAPB(o[1]=__builtin_amdgcn_mfma_f32_32x32x16_bf16(PAF(0),VFR(4),o[1],0,0,0), C0,4); \
    KRD(GL,0); GAPB(o[0]=__builtin_amdgcn_mfma_f32_32x32x16_bf16(PAF(1),VFR(1),o[0],0,0,0), C0,8); \
    KRD(GL,1); GAPB(o[1]=__builtin_amdgcn_mfma_f32_32x32x16_bf16(PAF(1),VFR(5),o[1],0,0,0), C0,12); \
    KRD(GL,2); GAPB(o[0]=__builtin_amdgcn_mfma_f32_32x32x16_bf16(PAF(2),VFR(2),o[0],0,0,0), C1,0); \
    KRD(GL,3); GAPB(o[1]=__builtin_amdgcn_mfma_f32_32x32x16_bf16(PAF(2),VFR(6),o[1],0,0,0), C1,4); \
    GAPB(o[0]=__builtin_amdgcn_mfma_f32_32x32x16_bf16(PAF(3),VFR(3),o[0],0,0,0), C1,8); \
    GAPB(o[1]=__builtin_amdgcn_mfma_f32_32x32x16_bf16(PAF(3),VFR(7),o[1],0,0,0), C1,12); \
    }while(0)
  int t=1;
  #undef CMASK
  #define CMASK(P0,P1,t) do{}while(0)
  for(;t+5<NT;t+=2){
    STEP(pB0,pB1,pA0,pA1,t,true,true,true);     WAIT_BAR(2); RESC(); ROT();
    STEP(pA0,pA1,pB0,pB1,t+1,true,true,true);   WAIT_BAR(2); RESC(); ROT();
  }
  #undef CMASK
  #define CMASK(P0,P1,t) do{}while(0)
  #define ENDW(tt) do{ if((tt)+3<NT){WAIT_BAR(2);} else if((tt)+2<NT){WAIT_BAR(1);} else {WAIT_BAR(0);} }while(0)
  for(;t+1<NT;t+=2){
    STEP(pB0,pB1,pA0,pA1,t,(t+3<NT),(t+1<NT),(t+1<NT));       ENDW(t);   RESC(); ROT();
    STEP(pA0,pA1,pB0,pB1,t+1,(t+4<NT),(t+2<NT),(t+2<NT));     ENDW(t+1); RESC(); ROT();
  }
  STEP(pB0,pB1,pA0,pA1,NT-1,false,false,false); RESC();
  { float sacc=pB0[0]+pB0[1]; _Pragma("unroll") for(int r=2;r<16;++r)sacc+=pB0[r]; _Pragma("unroll") for(int r=0;r<16;++r)sacc+=pB1[r]; l_reg+=sacc;
    pw0=(u32x4){PKW(pB0,0),PKW(pB0,2),PKW(pB0,4),PKW(pB0,6)};pw1=(u32x4){PKW(pB0,8),PKW(pB0,10),PKW(pB0,12),PKW(pB0,14)};pw2=(u32x4){PKW(pB1,0),PKW(pB1,2),PKW(pB1,4),PKW(pB1,6)};pw3=(u32x4){PKW(pB1,8),PKW(pB1,10),PKW(pB1,12),PKW(pB1,14)};
    SBAR(); pv(o,vb0+sl_cur,PAF(0),PAF(1),PAF(2),PAF(3)); }
  #undef PKW
  #undef PAF
  #undef VFR
  #undef PIN
  #undef MX3
  #undef GAPA
  #undef GAPB
  #undef EX
  #undef VRD
  #undef KRD
  #undef STEP
  #undef ENDW
  {auto rr=__builtin_amdgcn_permlane32_swap(__float_as_uint(l_reg),__float_as_uint(l_reg),false,false);l_reg=__uint_as_float(rr[0])+__uint_as_float(rr[1]);}
  if(hi==0)wsf[32+r32]=l_reg;asm volatile("s_waitcnt lgkmcnt(0)":::"memory");
  float rli[16];
  #pragma unroll
  for(int r=0;r<16;++r)rli[r]=__builtin_amdgcn_rcpf(wsf[32+crow(r,hi)]);
  bf16*Ow=Oh+(long)(q0+wid*QBLK)*DM;
  { bf16*stg=(bf16*)(shm+LDS_OST)+wid*2048;
    #pragma unroll
    for(int r=0;r<16;++r){const int orow=crow(r,hi);
      #pragma unroll
      for(int d0=0;d0<2;++d0)stg[orow*64+d0*32+r32]=__float2bfloat16(o[d0][r]*rli[r]);}
    asm volatile("s_waitcnt lgkmcnt(0)":::"memory");
    #pragma unroll
    for(int i=0;i<4;++i){const int row=i*8+(lane>>3),ch=lane&7; const u32x4 v=*(const u32x4*)(stg+row*64+ch*8); ATTN_STORE16(Ow+(long)row*DM+ch*8,v);} }
  __builtin_amdgcn_s_setprio(0);
  asm volatile("s_waitcnt lgkmcnt(0)\n\ts_barrier":::"memory");
  #undef DMA_K
  #undef DMA_V
  #undef CMASK
  #undef START
  #undef RESC
  #undef ROT
}
constexpr int ATTN_LDS_BYTES=LDS_BYTES;
#undef SBAR
#undef WAIT_BAR
}
#define GAS __attribute__((address_space(1)))
#define LAS __attribute__((address_space(3)))
typedef unsigned short bf16;
typedef unsigned v4u __attribute__((ext_vector_type(4)));
typedef unsigned v2u __attribute__((ext_vector_type(2)));
typedef float f32x4 __attribute__((ext_vector_type(4)));
typedef float f32x16 __attribute__((ext_vector_type(16)));
typedef short bf16x8 __attribute__((ext_vector_type(8)));
#define LDS_WAIT() asm volatile("s_waitcnt lgkmcnt(0)" ::: "memory")

constexpr int NWAVES = 8, NTHREADS = 512;
constexpr int BATCH = 4, SEQ = 8192, DMODEL = 1024, T = BATCH * SEQ, TH = T / 2, NIN = 8960, NPROJ = 4864, NGATE = 4096, FF = 4096;
constexpr float EPS = 1e-6f, C2 = 0.125f * 1.4426950408889634f, LOG2E = 1.4426950408889634f;
constexpr int C_AQ = 0, C_AK = 512, C_AV = 640, C_BX = 768, C_BY = 1280, C_CQ = 1792, C_CK = 2304, C_CV = 2432, C_DQ = 2560, C_DK = 3328, C_DV = 4096;
constexpr size_t MiB = 1u << 20;
constexpr size_t W_LAYER = 42 * MiB;
constexpr float Q_SW = 127.0f / 0.17f;
constexpr size_t OW_G8 = 10 * MiB;
constexpr int HP = FF + 64;
constexpr size_t OW_IN = 0, OW_PA = 17 * MiB + MiB / 2, OW_PB = OW_PA + MiB, OW_PC = OW_PB + MiB, OW_PD = OW_PC + MiB  , OW_OUT = OW_PD + MiB, OW_1 = OW_OUT + 2 * MiB, OW_G = OW_1 + 8 * MiB, OW_2 = OW_G + MiB / 2;
static_assert(OW_2 + (size_t)1024 * HP * 2 <= W_LAYER, "weight map");
constexpr size_t WS_W = 0, WS_HN = 84 * MiB, WS_PROJ = 148 * MiB, WS_GATES = 300 * MiB, WS_VTC = 364 * MiB, WS_VTD = 368 * MiB, WS_XC = 392 * MiB,
                 WS_LA = 408 * MiB, WS_MG = WS_LA, WS_U = 440 * MiB, WS_LSE = 472 * MiB, WS_SP = WS_LSE + 768 * 1024, WS_CTL = 473 * MiB, WS_RS = WS_CTL + 512 * 1024  , WS_KTC = 474 * MiB, WS_KTD = 478 * MiB, WS_AGG2 = 482 * MiB, WS_CARRY = 490 * MiB, WS_END = 502 * MiB, WS_H = WS_PROJ;
static_assert(WS_H + (size_t)T * HP * 2 <= WS_LA, "H overlay");
constexpr int LDS_BYTES = 147456;
constexpr int NSTEPS = 1 + 2 * (2 * 7 + 1 + 3 + 1);
constexpr int MISC_OFF = 131072 + 320;
constexpr size_t CTL_ZERO_BYTES = 16384 + 32768;
constexpr size_t WS_CM_OFF = 16384;

struct Args { const float* in[20]; float* out; unsigned char* ws; int ph_lo, ph_hi; };
struct Ctx { LAS unsigned char* lds; int tid, lane, wave, vcu, cb, G, gw, NGW; };

__device__ __forceinline__ float wave_sum(float v) {
#pragma unroll
    for (int o = 1; o < 64; o <<= 1) v += __shfl_xor(v, o);
    return v;
}
__device__ __forceinline__ unsigned f2bf(float f) { unsigned u = __builtin_bit_cast(unsigned, f); return (u + 0x7fffu + ((u >> 16) & 1u)) >> 16; }
typedef float f32x2_m __attribute__((ext_vector_type(2))); typedef __bf16 bf16x2_m __attribute__((ext_vector_type(2)));
__device__ __forceinline__ unsigned pk2(float lo, float hi) { const f32x2_m v = {lo, hi}; return __builtin_bit_cast(unsigned, __builtin_convertvector(v, bf16x2_m)); }
__device__ __forceinline__ float bf2f(unsigned short h) { return __uint_as_float((unsigned)h << 16); }
__device__ __forceinline__ float bflo(unsigned w) { return __uint_as_float(w << 16); }
__device__ __forceinline__ float bfhi(unsigned w) { return __uint_as_float(w & 0xffff0000u); }

__device__ __forceinline__ void transpose_item(const float* W, int K, int N, bf16* WT, LAS float* scr, int item, int lane, const float* gk = nullptr, int ldo = 0, int ldw = 0) {
    if (ldo == 0) ldo = K; if (ldw == 0) ldw = N; (void)gk;
    const int nblk = N / 32, kb = item / nblk, nb = item % nblk, k0 = 64 * kb, n0 = 32 * nb;
    float wv[32];
#pragma unroll
    for (int i = 0; i < 32; ++i) wv[i] = W[(size_t)(k0 + 2 * i + (lane >> 5)) * ldw + n0 + (lane & 31)];
#pragma unroll
    for (int i = 0; i < 32; ++i) scr[(2 * i + (lane >> 5)) * 33 + (lane & 31)] = wv[i];
    LDS_WAIT(); asm volatile("" ::: "memory");
    const int c = lane & 7;
#pragma unroll
    for (int j = 0; j < 4; ++j) { const int n = (lane >> 3) + 8 * j; const LAS float* s = scr + (8 * c) * 33 + n;
        v4u o; o.x = pk2(s[0 * 33], s[1 * 33]); o.y = pk2(s[2 * 33], s[3 * 33]); o.z = pk2(s[4 * 33], s[5 * 33]); o.w = pk2(s[6 * 33], s[7 * 33]);
        *(GAS v4u*)(WT + (size_t)(n0 + n) * ldo + k0 + 8 * c) = o; }
    LDS_WAIT(); asm volatile("" ::: "memory");
}
__device__ __forceinline__ unsigned q8(float v) { const int i = (int)rintf(v); return (unsigned)(i < -127 ? -127 : i > 127 ? 127 : i) & 255u; }
__device__ __forceinline__ unsigned pk4_fp8(float a, float b, float c_, float d) { return q8(a) | (q8(b) << 8) | (q8(c_) << 16) | (q8(d) << 24); }
__device__ __forceinline__ void transpose_item_f8(const float* W, int K, int N, int ldw, unsigned char* WT, LAS float* scr, int item, int lane, float scale, const unsigned* cm = nullptr) {
    const int nblk = N / 32, kb = item / nblk, nb = item % nblk, k0 = 64 * kb, n0 = 32 * nb;
    if (cm) scale = 127.0f / fmaxf(__uint_as_float(cm[n0 + (lane & 31)]), 1e-30f);
    float wv[32];
#pragma unroll
    for (int i = 0; i < 32; ++i) wv[i] = W[(size_t)(k0 + 2 * i + (lane >> 5)) * ldw + n0 + (lane & 31)];
#pragma unroll
    for (int i = 0; i < 32; ++i) scr[(2 * i + (lane >> 5)) * 33 + (lane & 31)] = wv[i] * scale;
    LDS_WAIT(); asm volatile("" ::: "memory");
    const int cc = lane & 7;
#pragma unroll
    for (int j = 0; j < 4; ++j) { const int n = (lane >> 3) + 8 * j; const LAS float* s = scr + (8 * cc) * 33 + n;
        v2u o; o.x = pk4_fp8(s[0 * 33], s[1 * 33], s[2 * 33], s[3 * 33]); o.y = pk4_fp8(s[4 * 33], s[5 * 33], s[6 * 33], s[7 * 33]);
        *(v2u*)(WT + (size_t)(n0 + n) * K + k0 + 8 * cc) = o; }
    LDS_WAIT(); asm volatile("" ::: "memory");
}
__device__ __forceinline__ void p0_prologue(const Ctx& c, const Args& a) {
    LAS float* scr = (LAS float*)(c.lds + c.wave * 16384);
    constexpr int I_IN = 16 * 152 + 16 * 128,     I_P = 8 * 32, I_PD = 4 * 32, I_O = 16 * 32, I_1 = 16 * 128, I_2 = 64 * 32, I_L = I_IN + 3 * I_P + I_PD + I_O + I_2;
    for (int it = c.gw; it < 2 * I_L; it += c.NGW) {
        const int l = it / I_L; int r = it % I_L; unsigned char* wl = a.ws + WS_W + (size_t)l * W_LAYER;
        if (r < 16 * 152) { transpose_item(a.in[2] + (size_t)l * 1024 * NIN, 1024, NPROJ, (bf16*)(wl + OW_IN), scr, r, c.lane, nullptr, 0, NIN); continue; } r -= 16 * 152;
        if (r < 16 * 128) { transpose_item_f8(a.in[2] + (size_t)l * 1024 * NIN + NPROJ, 1024, NGATE, NIN, wl + OW_G8, scr, r, c.lane, Q_SW); continue; } r -= 16 * 128;
        if (r < I_P) { transpose_item(a.in[11] + (size_t)l * 512 * 1024, 512, 1024, (bf16*)(wl + OW_PA), scr, r, c.lane); continue; } r -= I_P;
        if (r < I_P) { transpose_item(a.in[12] + (size_t)l * 512 * 1024, 512, 1024, (bf16*)(wl + OW_PB), scr, r, c.lane); continue; } r -= I_P;
        if (r < I_P) { transpose_item(a.in[13] + (size_t)l * 512 * 1024, 512, 1024, (bf16*)(wl + OW_PC), scr, r, c.lane); continue; } r -= I_P;
        if (r < I_PD) { transpose_item(a.in[14] + (size_t)l * 256 * 1024, 256, 1024, (bf16*)(wl + OW_PD), scr, r, c.lane, nullptr, 512); continue; } r -= I_PD;
        if (r < I_O) { transpose_item(a.in[15] + (size_t)l * 1024 * 1024, 1024, 1024, (bf16*)(wl + OW_OUT), scr, r, c.lane); continue; } r -= I_O;
        transpose_item(a.in[18] + (size_t)l * FF * 1024, FF, 1024, (bf16*)(wl + OW_2), scr, r, c.lane, nullptr, HP);
    }
    for (int idx = c.vcu * NTHREADS + c.tid; idx < 2 * 8 * FF; idx += c.G * NTHREADS) { const int l = idx / (8 * FF), seg = (idx / FF) & 7, n = idx % FF;
        const float* wp = a.in[17] + ((size_t)l * 1024 + seg * 128) * FF + n; float mx = 0.f;
#pragma unroll 16
        for (int i = 0; i < 128; ++i) mx = fmaxf(mx, fabsf(wp[(size_t)i * FF]));
        atomicMax((unsigned*)(a.ws + WS_CTL + WS_CM_OFF) + l * FF + n, __float_as_uint(mx)); }
    for (int idx = c.vcu * NTHREADS + c.tid; idx < 2048; idx += c.G * NTHREADS) ((float*)(a.ws + WS_SP))[idx] = 8.0f * log1pf(__expf(-a.in[9][idx]));
    const int gt = c.vcu * NTHREADS + c.tid, GT = c.G * NTHREADS;
    for (int idx = gt; idx < 2 * 2048 * 16; idx += GT) {
        const int l = idx / (2048 * 16), n = (idx >> 4) & 2047, k0 = (idx & 15) * 8;
        const int cl = n & 127, g = (n >> 7) & 1, cb = (n >> 8) & 3, d = n >> 10, nb = cb * 2 + (cl >> 6), dd = cl & 63;
        v4u o = (v4u){0u, 0u, 0u, 0u};
        if ((k0 >> 6) == (cl >> 6)) { const float* gw = a.in[7] + ((((size_t)(l * 2 + d) * 2 + g) * 8 + nb) * 64 + (k0 & 63)) * 64 + dd;
            o.x = pk2(gw[0], gw[64]); o.y = pk2(gw[128], gw[192]); o.z = pk2(gw[256], gw[320]); o.w = pk2(gw[384], gw[448]); }
        *(v4u*)((bf16*)(a.ws + WS_W + (size_t)l * W_LAYER + OW_G) + (size_t)n * 128 + k0) = o;
    }
}
__device__ __forceinline__ void convert_w1_i8(const Ctx& c, const Args& a) {
    LAS float* scr = (LAS float*)(c.lds + c.wave * 16384);
    for (int it = c.gw; it < 2 * 2048; it += c.NGW) { const int l = it / 2048, r = it % 2048;
        transpose_item_f8(a.in[17] + (size_t)l * 1024 * FF, 1024, FF, FF, a.ws + WS_W + (size_t)l * W_LAYER + OW_1, scr, r, c.lane, 0.f, (const unsigned*)(a.ws + WS_CTL + WS_CM_OFF) + l * FF); }
}
__device__ __forceinline__ float wave_max(float v) {
#pragma unroll
    for (int o = 1; o < 64; o <<= 1) v = fmaxf(v, __shfl_xor(v, o));
    return v;
}
__device__ __forceinline__ void rms_rows_bf16(const Ctx& c, const float* x, const float* g, bf16* o, int nrows, unsigned char* o8, float* rs) {
    f32x4 gv[4];
#pragma unroll
    for (int j = 0; j < 4; ++j) gv[j] = ((const f32x4*)g)[c.lane + 64 * j];
    for (int m = c.gw; m < nrows; m += 2 * c.NGW) {
        const f32x4* xa = (const f32x4*)(x + (size_t)m * DMODEL) + c.lane; const f32x4* xb = (const f32x4*)(x + (size_t)(m + c.NGW) * DMODEL) + c.lane; f32x4 va[4], vb[4]; float sa = 0.f, sb = 0.f;
#pragma unroll
        for (int j = 0; j < 4; ++j) { va[j] = xa[64 * j]; vb[j] = xb[64 * j]; }
#pragma unroll
        for (int j = 0; j < 4; ++j) { sa += (va[j].x * va[j].x + va[j].y * va[j].y) + (va[j].z * va[j].z + va[j].w * va[j].w); sb += (vb[j].x * vb[j].x + vb[j].y * vb[j].y) + (vb[j].z * vb[j].z + vb[j].w * vb[j].w); }
        const float ra = rsqrtf(wave_sum(sa) * (1.f / DMODEL) + EPS), rb = rsqrtf(wave_sum(sb) * (1.f / DMODEL) + EPS);
        v2u* oa = (v2u*)(o + (size_t)m * DMODEL) + c.lane; v2u* ob = (v2u*)(o + (size_t)(m + c.NGW) * DMODEL) + c.lane;
#pragma unroll
        for (int j = 0; j < 4; ++j) { v2u w; w.x = pk2(va[j].x * ra * gv[j].x, va[j].y * ra * gv[j].y); w.y = pk2(va[j].z * ra * gv[j].z, va[j].w * ra * gv[j].w); oa[64 * j] = w;
            w.x = pk2(vb[j].x * rb * gv[j].x, vb[j].y * rb * gv[j].y); w.y = pk2(vb[j].z * rb * gv[j].z, vb[j].w * rb * gv[j].w); ob[64 * j] = w; }
        float ma = 0.f, mb = 0.f;
#pragma unroll
        for (int j = 0; j < 4; ++j) { va[j] = va[j] * ra * gv[j]; vb[j] = vb[j] * rb * gv[j];
            ma = fmaxf(fmaxf(ma, fmaxf(fabsf(va[j].x), fabsf(va[j].y))), fmaxf(fabsf(va[j].z), fabsf(va[j].w))); mb = fmaxf(fmaxf(mb, fmaxf(fabsf(vb[j].x), fabsf(vb[j].y))), fmaxf(fabsf(vb[j].z), fabsf(vb[j].w))); }
        ma = fmaxf(wave_max(ma), 1e-20f); mb = fmaxf(wave_max(mb), 1e-20f);
        const float qa = 127.f / ma, qb = 127.f / mb; if (c.lane == 0) { rs[m] = ma * (1.f / 127.f); rs[m + c.NGW] = mb * (1.f / 127.f); }
#pragma unroll
        for (int j = 0; j < 4; ++j) { ((unsigned*)(o8 + (size_t)m * DMODEL))[c.lane + 64 * j] = pk4_fp8(va[j].x * qa, va[j].y * qa, va[j].z * qa, va[j].w * qa);
            ((unsigned*)(o8 + (size_t)(m + c.NGW) * DMODEL))[c.lane + 64 * j] = pk4_fp8(vb[j].x * qb, vb[j].y * qb, vb[j].z * qb, vb[j].w * qb); }
    }
}
__device__ __forceinline__ void rms_rows_b2b(const Ctx& c, const bf16* x, const float* g, bf16* o, int nrows, unsigned char* o8 = nullptr, float* rs = nullptr) {
    f32x4 gv[4];
#pragma unroll
    for (int j = 0; j < 4; ++j) gv[j] = ((const f32x4*)g)[c.lane * 4 + j];
    for (int m = c.gw; m < nrows; m += 4 * c.NGW) { v4u w[4][2]; float s[4];
#pragma unroll
        for (int r = 0; r < 4; ++r) { const v4u* xr = (const v4u*)(x + (size_t)(m + r * c.NGW) * DMODEL) + c.lane * 2; w[r][0] = xr[0]; w[r][1] = xr[1]; }
#pragma unroll
        for (int r = 0; r < 4; ++r) { float q = 0.f;
#pragma unroll
            for (int h = 0; h < 2; ++h) { const v4u t = w[r][h]; q += (bflo(t.x) * bflo(t.x) + bfhi(t.x) * bfhi(t.x)) + (bflo(t.y) * bflo(t.y) + bfhi(t.y) * bfhi(t.y)) + (bflo(t.z) * bflo(t.z) + bfhi(t.z) * bfhi(t.z)) + (bflo(t.w) * bflo(t.w) + bfhi(t.w) * bfhi(t.w)); }
            s[r] = q; }
#pragma unroll
        for (int r = 0; r < 4; ++r) { const float rr = rsqrtf(wave_sum(s[r]) * (1.f / DMODEL) + EPS); v4u* orow = (v4u*)(o + (size_t)(m + r * c.NGW) * DMODEL) + c.lane * 2;
#pragma unroll
            for (int h = 0; h < 2; ++h) { const v4u t = w[r][h]; const f32x4 ga = gv[2 * h], gb = gv[2 * h + 1]; v4u ov;
                ov.x = pk2(bflo(t.x) * rr * ga.x, bfhi(t.x) * rr * ga.y); ov.y = pk2(bflo(t.y) * rr * ga.z, bfhi(t.y) * rr * ga.w);
                ov.z = pk2(bflo(t.z) * rr * gb.x, bfhi(t.z) * rr * gb.y); ov.w = pk2(bflo(t.w) * rr * gb.z, bfhi(t.w) * rr * gb.w); if (o) orow[h] = ov; }
            if (o8) { float mx = 0.f;
#pragma unroll
                for (int h = 0; h < 2; ++h) { const v4u t = w[r][h]; const f32x4 ga = gv[2 * h], gb = gv[2 * h + 1];
                    mx = fmaxf(mx, fmaxf(fmaxf(fabsf(bflo(t.x) * ga.x), fabsf(bfhi(t.x) * ga.y)), fmaxf(fabsf(bflo(t.y) * ga.z), fabsf(bfhi(t.y) * ga.w))));
                    mx = fmaxf(mx, fmaxf(fmaxf(fabsf(bflo(t.z) * gb.x), fabsf(bfhi(t.z) * gb.y)), fmaxf(fabsf(bflo(t.w) * gb.z), fabsf(bfhi(t.w) * gb.w)))); }
                mx = fmaxf(wave_max(mx) * rr, 1e-20f); const float r16 = rr * (127.f / mx); if (c.lane == 0) rs[m + r * c.NGW] = mx * (1.f / 127.f);
#pragma unroll
                for (int h = 0; h < 2; ++h) { const v4u t = w[r][h]; const f32x4 ga = gv[2 * h], gb = gv[2 * h + 1]; v2u o;
                    o.x = pk4_fp8(bflo(t.x) * r16 * ga.x, bfhi(t.x) * r16 * ga.y, bflo(t.y) * r16 * ga.z, bfhi(t.y) * r16 * ga.w);
                    o.y = pk4_fp8(bflo(t.z) * r16 * gb.x, bfhi(t.z) * r16 * gb.y, bflo(t.w) * r16 * gb.z, bfhi(t.w) * r16 * gb.w);
                    *(v2u*)(o8 + (size_t)(m + r * c.NGW) * DMODEL + c.lane * 16 + h * 8) = o; } } }
    }
}
__device__ __forceinline__ void rms_final_b2f(const Ctx& c, const bf16* x, const float* g, float* o, int nrows) {
    f32x4 gv[4];
#pragma unroll
    for (int j = 0; j < 4; ++j) gv[j] = ((const f32x4*)g)[c.lane * 4 + j];
    for (int m = c.gw; m < nrows; m += 4 * c.NGW) { v4u w[4][2]; float s[4];
#pragma unroll
        for (int r = 0; r < 4; ++r) { const v4u* xr = (const v4u*)(x + (size_t)(m + r * c.NGW) * DMODEL) + c.lane * 2; w[r][0] = xr[0]; w[r][1] = xr[1]; }
#pragma unroll
        for (int r = 0; r < 4; ++r) { float q = 0.f;
#pragma unroll
            for (int h = 0; h < 2; ++h) { const v4u t = w[r][h]; q += (bflo(t.x) * bflo(t.x) + bfhi(t.x) * bfhi(t.x)) + (bflo(t.y) * bflo(t.y) + bfhi(t.y) * bfhi(t.y)) + (bflo(t.z) * bflo(t.z) + bfhi(t.z) * bfhi(t.z)) + (bflo(t.w) * bflo(t.w) + bfhi(t.w) * bfhi(t.w)); }
            s[r] = q; }
#pragma unroll
        for (int r = 0; r < 4; ++r) { const float rr = rsqrtf(wave_sum(s[r]) * (1.f / DMODEL) + EPS); f32x4* orow = (f32x4*)(o + (size_t)(m + r * c.NGW) * DMODEL) + c.lane * 4;
#pragma unroll
            for (int h = 0; h < 2; ++h) { const v4u t = w[r][h]; const f32x4 ga = gv[2 * h], gb = gv[2 * h + 1];
                orow[2 * h] = (f32x4){bflo(t.x) * rr * ga.x, bfhi(t.x) * rr * ga.y, bflo(t.y) * rr * ga.z, bfhi(t.y) * rr * ga.w};
                orow[2 * h + 1] = (f32x4){bflo(t.z) * rr * gb.x, bfhi(t.z) * rr * gb.y, bflo(t.w) * rr * gb.z, bfhi(t.w) * rr * gb.w}; } }
    }
}
__device__ __forceinline__ void sincos_rr(float ang, float& s, float& co) {
    const float n = rintf(ang * 0.15915494309189535f);
    float r = fmaf(-n, 6.28125f, ang); r = fmaf(-n, 1.9353071795864769e-3f, r);
    s = __sinf(r); co = __cosf(r);
}
__device__ __forceinline__ void rot8f(float (&x)[8], const float* cs, const float* sn, int xm, float scale) {
#pragma unroll
    for (int e = 0; e < 8; ++e) { const float xp = __shfl_xor(x[e], xm); x[e] = (x[e] * cs[e] + sn[e] * xp) * scale; }
}
template <bool DUMMY> __device__ __forceinline__ void rot8(v4u& w, const float* cs, const float* sn, int xm, float scale) {
    const v4u w0_ = w;
    float x[8] = {bflo(w.x), bfhi(w.x), bflo(w.y), bfhi(w.y), bflo(w.z), bfhi(w.z), bflo(w.w), bfhi(w.w)};
    rot8f(x, cs, sn, xm, scale);
    w.x = pk2(x[0], x[1]); w.y = pk2(x[2], x[3]); w.z = pk2(x[4], x[5]); w.w = pk2(x[6], x[7]);
    if (DUMMY) { asm volatile("" :: "v"(w.x), "v"(w.y), "v"(w.z), "v"(w.w)); w = w0_; }
}
template <bool DUMMY = false> __device__ __forceinline__ void p3_prep(const Ctx& c, bf16* PROJ, bf16* XC, bf16* VTC, bf16* VTD, bf16* KTC, bf16* KTD, const float* qkg, const float* convw, const float* convb) {
    const int lane = c.lane, l8 = lane & 7, t8 = lane >> 3;
    const float L2T = 13.287712379549449f;
    for (int grp = c.gw; grp < TH / 8; grp += c.NGW) {
        const int tl = grp * 8 + t8, s = tl & (SEQ - 1);
        float cs1[8], sn1[8], csa[8], sna[8], gq[8], gk[8];
#pragma unroll
        for (int e = 0; e < 8; ++e) { const int i = l8 * 8 + e; float sv, cv;
            sincos_rr((float)s * __builtin_amdgcn_exp2f(-(float)(2 * (i & 31)) * (1.f / 64.f) * L2T), sv, cv); cs1[e] = cv; sn1[e] = (i & 32) ? sv : -sv;
            sincos_rr((float)((i & 32) ? (s & 63) : (s >> 6)) * __builtin_amdgcn_exp2f(-(float)(2 * (i & 15)) * (1.f / 32.f) * L2T), sv, cv); csa[e] = cv; sna[e] = (i & 16) ? sv : -sv;
            gq[e] = qkg[i]; gk[e] = qkg[64 + i]; }
        bf16* row = PROJ + (size_t)tl * NPROJ + l8 * 8;
#pragma unroll 10
        for (int h = 0; h < 10; ++h) { v4u w = *(const v4u*)(row + h * 64); const v4u w0_ = w;
            float x[8] = {bflo(w.x), bfhi(w.x), bflo(w.y), bfhi(w.y), bflo(w.z), bfhi(w.z), bflo(w.w), bfhi(w.w)}; float q = 0.f;
#pragma unroll
            for (int e = 0; e < 8; ++e) q += x[e] * x[e];
            q += __shfl_xor(q, 1); q += __shfl_xor(q, 2); q += __shfl_xor(q, 4);
            const float r = rsqrtf(q * (1.f / 64.f) + EPS);
#pragma unroll
            for (int e = 0; e < 8; ++e) x[e] *= r * (h < 8 ? gq[e] : gk[e]);
            rot8f(x, csa, sna, 2, h < 8 ? C2 : 1.f);
            w.x = pk2(x[0], x[1]); w.y = pk2(x[2], x[3]); w.z = pk2(x[4], x[5]); w.w = pk2(x[6], x[7]); if (DUMMY) { asm volatile("" :: "v"(w.x), "v"(w.y), "v"(w.z), "v"(w.w)); w = w0_; } *(v4u*)(row + h * 64) = w; }
#pragma unroll 10
        for (int h = 0; h < 10; ++h) { v4u w = *(const v4u*)(row + C_CQ + h * 64); rot8<DUMMY>(w, cs1, sn1, 4, h < 8 ? C2 : 1.f);
            if (h < 8) *(v4u*)(row + C_CQ + h * 64) = w;
            else *(v4u*)(KTC + ((size_t)(((tl >> 13) * 2 + (h - 8)) * 256 + (s >> 5)) * 2048) + (l8 * 32 + (s & 31)) * 8) = w; }
#pragma unroll 12
        for (int h = 0; h < 24; ++h) { v4u w = *(const v4u*)(row + C_DQ + h * 64); rot8<DUMMY>(w, cs1, sn1, 4, h < 12 ? C2 : 1.f);
            if (h < 12) *(v4u*)(row + C_DQ + h * 64) = w;
            else { const int gh = h - 12, sh = 2 * (gh >> 2), P = (s & ((1 << sh) - 1)) * (SEQ >> sh) + (s >> sh);
                *(v4u*)(KTD + ((size_t)(((tl >> 13) * 12 + gh) * 256 + (P >> 5)) * 2048) + (l8 * 32 + (P & 31)) * 8) = w; } }
    }
    { float cw[4][8], cb[8];
#pragma unroll
      for (int e = 0; e < 8; ++e) { cb[e] = convb[8 * lane + e];
#pragma unroll
          for (int j = 0; j < 4; ++j) cw[j][e] = convw[j * 512 + 8 * lane + e]; }
      for (int grp = c.gw; grp < TH / 8; grp += c.NGW) { const int tl0 = grp * 8, s0 = tl0 & (SEQ - 1);
          v4u xr[11];
#pragma unroll
          for (int j = 0; j < 11; ++j) { const int sp = s0 - 2 + j; xr[j] = (sp >= 0 && sp < SEQ) ? *(const v4u*)(PROJ + (size_t)(tl0 - 2 + j) * NPROJ + C_BX + 8 * lane) : (v4u){0u, 0u, 0u, 0u}; }
#pragma unroll
          for (int t = 0; t < 8; ++t) { float acc[8];
#pragma unroll
              for (int e = 0; e < 8; ++e) acc[e] = cb[e];
#pragma unroll
              for (int j = 0; j < 4; ++j) { const v4u xw = xr[t + j];
                  acc[0] += bflo(xw.x) * cw[j][0]; acc[1] += bfhi(xw.x) * cw[j][1]; acc[2] += bflo(xw.y) * cw[j][2]; acc[3] += bfhi(xw.y) * cw[j][3];
                  acc[4] += bflo(xw.z) * cw[j][4]; acc[5] += bfhi(xw.z) * cw[j][5]; acc[6] += bflo(xw.w) * cw[j][6]; acc[7] += bfhi(xw.w) * cw[j][7]; }
              v4u o; o.x = pk2(acc[0], acc[1]); o.y = pk2(acc[2], acc[3]); o.z = pk2(acc[4], acc[5]); o.w = pk2(acc[6], acc[7]);
              *(v4u*)(XC + (size_t)(tl0 + t) * 512 + 8 * lane) = o; } } }
    LAS bf16* scr = (LAS bf16*)(c.lds + c.wave * 16384);
    for (int it = c.gw; it < 2 * 14 * 128; it += c.NGW) {
        const int ch = it & 127, vh = (it >> 7) % 14, b = it / (14 * 128), s0 = ch * 64;
        const bf16* src = PROJ + (size_t)(b * SEQ + s0) * NPROJ + (vh < 2 ? C_CV + vh * 64 : C_DV + (vh - 2) * 64);
#pragma unroll
        for (int i = 0; i < 8; ++i) { const int r = i * 8 + (lane >> 3), cc = lane & 7; *(LAS v4u*)(scr + r * 72 + cc * 8) = *(const v4u*)(src + (size_t)r * NPROJ + cc * 8); }
        LDS_WAIT(); asm volatile("" ::: "memory");
        const int sh = vh < 2 ? 0 : 2 * ((vh - 2) >> 2), L = SEQ >> sh;
        bf16* dst = vh < 2 ? VTC + (size_t)(b * 2 + vh) * 256 * 2048 : VTD + (size_t)(b * 12 + (vh - 2)) * 256 * 2048;
        const int d = lane;
#pragma unroll 4
        for (int gq = 0; gq < 16; ++gq) { const int r = gq >> (4 - sh), q = gq & ((16 >> sh) - 1);
            const int P = r * L + (s0 >> sh) + 4 * q, kk = P & 31, mh = (kk >> 4) & 1, j = (kk >> 3) & 1, hi = (kk >> 2) & 1;
            const int t0 = ((4 * q) << sh) + r, ts = 1 << sh;
            v2u o; o.x = (unsigned)scr[t0 * 72 + d] | ((unsigned)scr[(t0 + ts) * 72 + d] << 16); o.y = (unsigned)scr[(t0 + 2 * ts) * 72 + d] | ((unsigned)scr[(t0 + 3 * ts) * 72 + d] << 16);
            *(v2u*)(dst + (size_t)(P >> 5) * 2048 + ((((d >> 5) * 2 + mh) * 2 + hi) * 32 + (d & 31)) * 8 + 4 * j) = o; }
        LDS_WAIT(); asm volatile("" ::: "memory");
    }
}
__device__ __forceinline__ int crow(int r, int hi) { return (r & 3) + 8 * (r >> 2) + 4 * hi; }
template <bool SINK, int NT, int PD>
__device__ __forceinline__ void banded_item(const bf16* Q, long qstride, const bf16* KT, const bf16* VT, bf16* O, long ostride, float* lse, long lsestride,
                                            int L, int q0, float sink2, int lane) {
    constexpr int hw = (NT - 1) * 16;
    const int r32 = lane & 31, hi = lane >> 5, qq = q0 + r32;
    int t_lo = (hw - q0) / 32; if (t_lo < 0) t_lo = 0;
    int t_hi = (L - q0 + hw) / 32; if (t_hi > NT) t_hi = NT;
    const long tb = (long)((q0 - hw) / 32);
    const bf16* kp = KT + tb * 2048 + (hi * 32 + r32) * 8;
    const bf16* vp = VT + tb * 2048 + (hi * 32 + r32) * 8;
    bf16x8 qf[4], kf[PD][4], vf[PD][4];
#pragma unroll
    for (int d0 = 0; d0 < 4; ++d0) qf[d0] = *(const bf16x8*)(Q + (long)qq * qstride + d0 * 16 + hi * 8);
#pragma unroll
    for (int t = 0; t < PD; ++t) if (t >= t_lo && t < t_hi) {
#pragma unroll
        for (int i = 0; i < 4; ++i) { kf[t][i] = *(const bf16x8*)(kp + (long)t * 2048 + i * 512); vf[t][i] = *(const bf16x8*)(vp + (long)t * 2048 + i * 512); } }
    float mhat = SINK ? sink2 : -1e30f, l = 0.f; f32x16 o0 = {}, o1 = {};
#pragma unroll
    for (int kt = 0; kt < NT; ++kt) { constexpr int dummy_ = 0; (void)dummy_; const int sl = kt % PD;
        if (kt >= t_lo && kt < t_hi) { const int k0 = q0 - hw + 32 * kt;
            f32x16 sacc = {};
#pragma unroll
            for (int d0 = 0; d0 < 4; ++d0) sacc = __builtin_amdgcn_mfma_f32_32x32x16_bf16(kf[sl][d0], qf[d0], sacc, 0, 0, 0);
            const bool interior = (32 * kt - hw + 31 <= hw) && (32 * kt - hw - 31 >= -hw);
            float rm = -1e30f; unsigned vmask = interior ? 0xffffu : 0u;
#pragma unroll
            for (int r = 0; r < 16; ++r) { if (interior) { rm = fmaxf(rm, sacc[r]); } else { const int dk = k0 + crow(r, hi) - qq; const bool ok = (dk <= hw && dk >= -hw); vmask |= ok ? (1u << r) : 0u; rm = fmaxf(rm, ok ? sacc[r] : -1e30f); } }
            rm = fmaxf(rm, __shfl_xor(rm, 32));
            if (__any(rm > mhat + 8.f)) { const float mn = fmaxf(mhat, rm), f = __builtin_amdgcn_exp2f(mhat - mn); mhat = mn; l *= f;
#pragma unroll
                for (int r = 0; r < 16; ++r) { const float fr = __shfl(f, crow(r, hi)); o0[r] *= fr; o1[r] *= fr; } }
            float p[16];
#pragma unroll
            for (int r = 0; r < 16; ++r) { p[r] = ((vmask >> r) & 1u) ? __builtin_amdgcn_exp2f(sacc[r] - mhat) : 0.f; l += p[r]; }
            v4u pa0, pa1; pa0.x = pk2(p[0], p[1]); pa0.y = pk2(p[2], p[3]); pa0.z = pk2(p[4], p[5]); pa0.w = pk2(p[6], p[7]);
            pa1.x = pk2(p[8], p[9]); pa1.y = pk2(p[10], p[11]); pa1.z = pk2(p[12], p[13]); pa1.w = pk2(p[14], p[15]);
            const bf16x8 a0 = __builtin_bit_cast(bf16x8, pa0), a1 = __builtin_bit_cast(bf16x8, pa1);
            o0 = __builtin_amdgcn_mfma_f32_32x32x16_bf16(a0, vf[sl][0], o0, 0, 0, 0); o0 = __builtin_amdgcn_mfma_f32_32x32x16_bf16(a1, vf[sl][1], o0, 0, 0, 0);
            o1 = __builtin_amdgcn_mfma_f32_32x32x16_bf16(a0, vf[sl][2], o1, 0, 0, 0); o1 = __builtin_amdgcn_mfma_f32_32x32x16_bf16(a1, vf[sl][3], o1, 0, 0, 0); }
        if (kt + PD < NT) { const int tn = kt + PD; if (tn >= t_lo && tn < t_hi) {
#pragma unroll
            for (int i = 0; i < 4; ++i) { kf[sl][i] = *(const bf16x8*)(kp + (long)tn * 2048 + i * 512); vf[sl][i] = *(const bf16x8*)(vp + (long)tn * 2048 + i * 512); } } } }
    l += __shfl_xor(l, 32); if (SINK) l += __builtin_amdgcn_exp2f(sink2 - mhat);
    const float rl = __builtin_amdgcn_rcpf(l);
#pragma unroll
    for (int r = 0; r < 16; ++r) { const int qr = crow(r, hi); const float f = __shfl(rl, qr);
        bf16* op = O + (long)(q0 + qr) * ostride + r32; const unsigned w = pk2(o0[r] * f, o1[r] * f); op[0] = (bf16)(w & 0xffffu); op[32] = (bf16)(w >> 16); }
    if (lse && hi == 0) lse[(long)qq * lsestride] = mhat + __builtin_amdgcn_logf(l);
}
__device__ __forceinline__ void p4_banded(const Ctx& c, bf16* PROJ, const bf16* VTC, const bf16* VTD, const bf16* KTC, const bf16* KTD, float* LSE, const float* sink, bool dummy = false) {
    constexpr int NC = 2 * 2 * 256 * 4, ND = 2 * 3 * 1024;
    for (int it = c.gw; it < NC + ND; it += c.NGW) {
        if (it < NC) { const int hq = it & 3, ti = (it >> 2) & 255, kvh = (it >> 10) & 1, b = it >> 11, h = kvh * 4 + hq;
            bf16* Q = PROJ + (size_t)b * SEQ * NPROJ + C_CQ + h * 64; const size_t to = (size_t)(b * 2 + kvh) * 256 * 2048;
            banded_item<true, 9, 3>(Q, NPROJ, KTC + to, VTC + to, dummy ? Q - C_CQ + C_BX : Q, NPROJ, nullptr, 0, SEQ, ti * 32, sink[h] * LOG2E, c.lane);
        } else { const int r = it - NC; const int b = r / 3072, g = (r / 1024) % 3, w = r & 1023, h = w >> 8, v = w & 255;
            const int sh = 2 * g, dil = 1 << sh, L = SEQ >> sh, tpr = L / 32, res = v / tpr, ti = v % tpr, gh = g * 4 + h;
            bf16* Q = PROJ + ((size_t)b * SEQ + res) * NPROJ + C_DQ + gh * 64; const size_t to = ((size_t)(b * 12 + gh) * 256 + (size_t)res * tpr) * 2048;
            banded_item<false, 5, 4>(Q, (long)dil * NPROJ, KTD + to, VTD + to, dummy ? Q - C_DQ + C_DV : Q, (long)dil * NPROJ,
                               LSE + ((size_t)b * SEQ + res) * 12 + gh, (long)dil * 12, L, ti * 32, 0.f, c.lane); }
    }
}
constexpr int SCH = 16, NCH = SEQ / SCH;
__device__ __forceinline__ void p5_scan1_combine(const Ctx& c, const bf16* LA, const bf16* U, float* AGG, const bf16* PROJ, const float* LSE, bf16* YD) {
    for (int it = c.vcu * 4 + (c.tid >> 7); it < 2 * NCH; it += c.G * 4) { const int b = it / NCH, j = it % NCH, c4 = (c.tid & 127) * 4;
#pragma unroll
        for (int dir = 0; dir < 2; ++dir) { const size_t ro = ((size_t)dir * TH + b * SEQ + j * SCH) * 512 + c4;
            v2u lw[SCH], uw[SCH];
#pragma unroll
            for (int p = 0; p < SCH; ++p) { lw[p] = *(const v2u*)(LA + ro + (size_t)p * 512); uw[p] = *(const v2u*)(U + ro + (size_t)p * 512); }
            float h[4] = {0.f, 0.f, 0.f, 0.f}, sa[4] = {0.f, 0.f, 0.f, 0.f};
#pragma unroll
            for (int i = 0; i < SCH; ++i) { const int p = dir ? SCH - 1 - i : i;
                const float l0 = bflo(lw[p].x), l1 = bfhi(lw[p].x), l2 = bflo(lw[p].y), l3 = bfhi(lw[p].y);
                h[0] = __builtin_amdgcn_exp2f(l0) * h[0] + bflo(uw[p].x); h[1] = __builtin_amdgcn_exp2f(l1) * h[1] + bfhi(uw[p].x);
                h[2] = __builtin_amdgcn_exp2f(l2) * h[2] + bflo(uw[p].y); h[3] = __builtin_amdgcn_exp2f(l3) * h[3] + bfhi(uw[p].y);
                sa[0] += l0; sa[1] += l1; sa[2] += l2; sa[3] += l3; }
            const int q = dir ? NCH - 1 - j : j;
#pragma unroll
            for (int e = 0; e < 4; ++e) { float2 v; v.x = sa[e]; v.y = h[e]; ((float2*)AGG)[((size_t)(b * 2 + dir) * 512 + c4 + e) * NCH + q] = v; } } }
    for (int t0 = c.gw; t0 < TH; t0 += 4 * c.NGW) { const int h = c.lane >> 4, d4 = (c.lane & 15) * 4;
        float ls[4][3]; v2u av[4], bv_[4], cv[4];
#pragma unroll
        for (int u = 0; u < 4; ++u) { const size_t tl = (size_t)t0 + (size_t)u * c.NGW; if (tl >= (size_t)TH) continue; ls[u][0] = LSE[tl * 12 + h]; ls[u][1] = LSE[tl * 12 + 4 + h]; ls[u][2] = LSE[tl * 12 + 8 + h];
            const bf16* pr = PROJ + tl * NPROJ + C_DQ + h * 64 + d4; av[u] = *(const v2u*)pr; bv_[u] = *(const v2u*)(pr + 256); cv[u] = *(const v2u*)(pr + 512); }
#pragma unroll
        for (int u = 0; u < 4; ++u) { const size_t tl = (size_t)t0 + (size_t)u * c.NGW; if (tl >= (size_t)TH) continue; const float l0 = ls[u][0], l1 = ls[u][1], l2 = ls[u][2];
            const float mx = fmaxf(l0, fmaxf(l1, l2)); float w0 = __builtin_amdgcn_exp2f(l0 - mx), w1 = __builtin_amdgcn_exp2f(l1 - mx), w2 = __builtin_amdgcn_exp2f(l2 - mx);
            const float inv = __builtin_amdgcn_rcpf(w0 + w1 + w2); w0 *= inv; w1 *= inv; w2 *= inv;
            const v2u a = av[u], bq = bv_[u], cq = cv[u];
            v2u o; o.x = pk2(w0 * bflo(a.x) + w1 * bflo(bq.x) + w2 * bflo(cq.x), w0 * bfhi(a.x) + w1 * bfhi(bq.x) + w2 * bfhi(cq.x));
            o.y = pk2(w0 * bflo(a.y) + w1 * bflo(bq.y) + w2 * bflo(cq.y), w0 * bfhi(a.y) + w1 * bfhi(bq.y) + w2 * bfhi(cq.y));
            *(v2u*)(YD + tl * NPROJ + C_DK + h * 64 + d4) = o; } }
}
__device__ __forceinline__ float gelu_tanh(float x) { const float z = 0.7978845608028654f * (x + 0.044715f * x * x * x); const float e = __builtin_amdgcn_exp2f(2.f * LOG2E * z); return 0.5f * x * (2.f - 2.f * __builtin_amdgcn_rcpf(1.f + e)); }
__device__ __forceinline__ void p5b_carry(const Ctx& c, const float* AGG, float* CARRY) {
    for (int w = c.gw; w < 2 * 2 * 512; w += c.NGW) { const float2* ag = (const float2*)AGG + (size_t)w * NCH + c.lane * 8;
        float2 v[8];
#pragma unroll
        for (int i = 0; i < 8; ++i) v[i] = ag[i];
        float A = 0.f, H = 0.f;
#pragma unroll
        for (int i = 0; i < 8; ++i) { H = __builtin_amdgcn_exp2f(v[i].x) * H + v[i].y; A += v[i].x; }
#pragma unroll
        for (int d = 1; d < 64; d <<= 1) { const float Ap = __shfl_up(A, d), Hp = __shfl_up(H, d); if (c.lane >= d) { H = __builtin_amdgcn_exp2f(A) * Hp + H; A += Ap; } }
        float cin = __shfl_up(H, 1); if (c.lane == 0) cin = 0.f;
        float* co = CARRY + (size_t)w * NCH + c.lane * 8; f32x4 o0, o1;
        o0.x = cin; cin = __builtin_amdgcn_exp2f(v[0].x) * cin + v[0].y; o0.y = cin; cin = __builtin_amdgcn_exp2f(v[1].x) * cin + v[1].y; o0.z = cin; cin = __builtin_amdgcn_exp2f(v[2].x) * cin + v[2].y; o0.w = cin; cin = __builtin_amdgcn_exp2f(v[3].x) * cin + v[3].y;
        o1.x = cin; cin = __builtin_amdgcn_exp2f(v[4].x) * cin + v[4].y; o1.y = cin; cin = __builtin_amdgcn_exp2f(v[5].x) * cin + v[5].y; o1.z = cin; cin = __builtin_amdgcn_exp2f(v[6].x) * cin + v[6].y; o1.w = cin;
        *(f32x4*)co = o0; *(f32x4*)(co + 4) = o1; }
}
__device__ __forceinline__ void p6_scan3(const Ctx& c, const bf16* LA, const bf16* U, const float* CARRY, const bf16* PROJ, bf16* YB) {
    for (int it = c.vcu * 4 + (c.tid >> 7); it < 2 * NCH; it += c.G * 4) { const int b = it / NCH, j = it % NCH, c4 = (c.tid & 127) * 4;
        const size_t r0 = (size_t)b * SEQ + j * SCH;
        float hf[4], hb[4];
#pragma unroll
        for (int e = 0; e < 4; ++e) { hf[e] = CARRY[((size_t)(b * 2 + 0) * 512 + c4 + e) * NCH + j]; hb[e] = CARRY[((size_t)(b * 2 + 1) * 512 + c4 + e) * NCH + (NCH - 1 - j)]; }
        v2u lw[SCH], uw[SCH]; float hs[SCH][4];
#pragma unroll
        for (int p = 0; p < SCH; ++p) { lw[p] = *(const v2u*)(LA + (r0 + p) * 512 + c4); uw[p] = *(const v2u*)(U + (r0 + p) * 512 + c4); }
#pragma unroll
        for (int p = 0; p < SCH; ++p) {
            hf[0] = __builtin_amdgcn_exp2f(bflo(lw[p].x)) * hf[0] + bflo(uw[p].x); hf[1] = __builtin_amdgcn_exp2f(bfhi(lw[p].x)) * hf[1] + bfhi(uw[p].x);
            hf[2] = __builtin_amdgcn_exp2f(bflo(lw[p].y)) * hf[2] + bflo(uw[p].y); hf[3] = __builtin_amdgcn_exp2f(bfhi(lw[p].y)) * hf[3] + bfhi(uw[p].y);
            hs[p][0] = hf[0]; hs[p][1] = hf[1]; hs[p][2] = hf[2]; hs[p][3] = hf[3]; }
#pragma unroll
        for (int p = 0; p < SCH; ++p) { lw[p] = *(const v2u*)(LA + ((size_t)TH + r0 + p) * 512 + c4); uw[p] = *(const v2u*)(U + ((size_t)TH + r0 + p) * 512 + c4); }
        v2u yw[SCH];
#pragma unroll
        for (int p = 0; p < SCH; ++p) yw[p] = *(const v2u*)(PROJ + (r0 + p) * NPROJ + C_BY + c4);
#pragma unroll
        for (int p = SCH - 1; p >= 0; --p) {
            hb[0] = __builtin_amdgcn_exp2f(bflo(lw[p].x)) * hb[0] + bflo(uw[p].x); hb[1] = __builtin_amdgcn_exp2f(bfhi(lw[p].x)) * hb[1] + bfhi(uw[p].x);
            hb[2] = __builtin_amdgcn_exp2f(bflo(lw[p].y)) * hb[2] + bflo(uw[p].y); hb[3] = __builtin_amdgcn_exp2f(bfhi(lw[p].y)) * hb[3] + bfhi(uw[p].y);
            v2u o; o.x = pk2((hs[p][0] + hb[0]) * gelu_tanh(bflo(yw[p].x)), (hs[p][1] + hb[1]) * gelu_tanh(bfhi(yw[p].x)));
            o.y = pk2((hs[p][2] + hb[2]) * gelu_tanh(bflo(yw[p].y)), (hs[p][3] + hb[3]) * gelu_tanh(bfhi(yw[p].y)));
            *(v2u*)(YB + (r0 + p) * NPROJ + C_BX + c4) = o; }
    }
}
typedef __attribute__((address_space(1))) unsigned gu32;
#define RLX_AGENT __ATOMIC_RELAXED, __HIP_MEMORY_SCOPE_AGENT
#define XB_TMO      128
#define XB_XCNT(j)  (256  + 64 * (j))
#define XB_XSUB(j)  (1280 + 64 * (j))
#define XB_XGEN(j)  (2304 + 64 * (j))
#define XB_TOP      3328
#define XB_TOPGEN   3392
#define XCD_BAR_WORDS 3456
#define XB_SPIN_CAP (1u << 18)

__device__ __forceinline__ unsigned xb_ld(unsigned* p)              { return __hip_atomic_load(p, __ATOMIC_RELAXED, __HIP_MEMORY_SCOPE_AGENT); }
__device__ __forceinline__ unsigned xb_add(unsigned* p, unsigned v) { return __hip_atomic_fetch_add(p, v, __ATOMIC_RELAXED, __HIP_MEMORY_SCOPE_AGENT); }
__device__ __forceinline__ unsigned xb_xcc_id() { return (unsigned)__builtin_amdgcn_s_getreg((3 << 11) | 20) & 0xFu; }
#define XB_SPIN(cond, bar) do { unsigned _sp = 0; while (cond) { __builtin_amdgcn_s_sleep(1); \
    if ((++_sp & 255u) == 0u) { if (xb_ld(&(bar)[XB_TMO])) break; if (_sp > XB_SPIN_CAP) { atomicAdd(&(bar)[XB_TMO], 1u); break; } } } } while (0)

struct XcdBarrier {
    unsigned* bar; unsigned x;
    volatile LAS unsigned* st;
};

__device__ __forceinline__ XcdBarrier xcd_barrier_post(unsigned* bar, volatile LAS unsigned* st) {
    XcdBarrier b; b.bar = bar; b.x = xb_xcc_id(); b.st = st;
    if (threadIdx.x == 0) (void)xb_add(&bar[XB_XCNT(b.x)], 1u);
    return b;
}
__device__ __forceinline__ void xcd_barrier_complete(unsigned* bar, unsigned x, unsigned& nloc, unsigned& nx) {
    const unsigned G = gridDim.x * gridDim.y * gridDim.z;
    unsigned sum, cnt, mine, sp = 0u;
    for (;;) {
        sum = 0u; cnt = 0u; mine = 0u;
#pragma unroll
        for (unsigned j = 0; j < 16; ++j) { const unsigned c = xb_ld(&bar[XB_XCNT(j)]); sum += c; cnt += (c > 0u) ? 1u : 0u; mine = (j == x) ? c : mine; }
        if (sum == G) break;
        __builtin_amdgcn_s_sleep(1);
        if ((++sp & 255u) == 0u) { if (xb_ld(&bar[XB_TMO])) break; if (sp > XB_SPIN_CAP) { atomicAdd(&bar[XB_TMO], 1u); break; } }
    }
    nloc = mine > 0u ? mine : 1u; nx = cnt > 0u ? cnt : 1u;
}

__device__ __forceinline__ void xcd_barrier(const XcdBarrier& b) {
    asm volatile("s_waitcnt vmcnt(0)" ::: "memory");
    __syncthreads();
    if (threadIdx.x == 0) {
        unsigned* bar = b.bar;
        __builtin_amdgcn_s_waitcnt(0);
        unsigned nloc = b.st[0], nx = b.st[1];
        if (nloc == 0u) { xcd_barrier_complete(bar, b.x, nloc, nx); b.st[0] = nloc; b.st[1] = nx; }
        const unsigned old = xb_add(&bar[XB_XSUB(b.x)], 1u);
        const unsigned gen = old / nloc;
        if (old + 1u == (gen + 1u) * nloc) {
            __builtin_amdgcn_fence(__ATOMIC_RELEASE, "agent");
            asm volatile("s_waitcnt vmcnt(0)" ::: "memory");
            const unsigned og = xb_add(&bar[XB_TOP], 1u);
            const unsigned tg = og / nx;
            if (og + 1u == (tg + 1u) * nx) xb_add(&bar[XB_TOPGEN], 1u);
            else XB_SPIN(xb_ld(&bar[XB_TOPGEN]) == tg, bar);
            __builtin_amdgcn_fence(__ATOMIC_ACQUIRE, "agent");
            xb_add(&bar[XB_XGEN(b.x)], 1u);
            asm volatile("s_waitcnt vmcnt(0)" ::: "memory");
        } else {
            XB_SPIN(xb_ld(&bar[XB_XGEN(b.x)]) == gen, bar);
            __builtin_amdgcn_fence(__ATOMIC_ACQUIRE, "agent");
            asm volatile("s_waitcnt vmcnt(0)" ::: "memory");
        }
    }
    __syncthreads();
}
__device__ __forceinline__ void p6_attn(const Ctx& c, bf16* PROJ, char* shm, const float* qkg, int ocol = C_AQ) {
    const float mbound = wave_max(fabsf(qkg[c.lane])) * wave_max(fabsf(qkg[64 + c.lane])) * (64.0f * C2 * 1.02f);
    for (int i = 0;; ++i) { int uidx; if (c.G == 256) { if (i >= 2) break; uidx = c.vcu * 2 + i; } else { uidx = c.vcu + i * c.G; if (uidx >= 512) break; }
        const int bk = uidx >> 7, rem = uidx & 127, hq = rem >> 5, qb = rem & 31, b = bk >> 1, kvh = bk & 1, h = kvh * 4 + hq;
        bf16* base = PROJ + (size_t)b * SEQ * NPROJ;
        attn_body::attn_unit<8>(qb, (const attn_body::bf16*)(base + C_AQ + h * 64), (const attn_body::bf16*)(base + C_AK + kvh * 64), (const attn_body::bf16*)(base + C_AV + kvh * 64),
                                (attn_body::bf16*)(base + ocol + h * 64), shm, mbound); }
}
__global__ void __launch_bounds__(NTHREADS, 2) fwd(Args a) {
    extern __shared__ __attribute__((aligned(16))) unsigned char lds[];
    cg::grid_group grid = cg::this_grid();
    const Args& aa = a;
    for (int u = threadIdx.x; u < (LDS_BYTES - 131072) / 4; u += NTHREADS) ((LAS unsigned*)((LAS unsigned char*)lds + 131072))[u] = 0u;
    __syncthreads();
    XcdBarrier bar = xcd_barrier_post((unsigned*)(a.ws + WS_CTL), (volatile LAS unsigned*)((LAS unsigned char*)lds + MISC_OFF) + 8);
#define MISCW ((volatile LAS unsigned*)((LAS unsigned char*)lds + MISC_OFF))
    if (threadIdx.x == 0) { const unsigned xcc = xb_xcc_id(); MISCW[16] = xb_add((unsigned*)(a.ws + WS_CTL) + 3584 + 32 * xcc, 1u); MISCW[17] = xcc; MISCW[18] = blockIdx.x; }
    __syncthreads();
#define MKCTX() Ctx c; { int t_ = threadIdx.x; asm volatile("" : "+v"(t_)); c.lds = (LAS unsigned char*)lds; c.tid = t_; c.lane = t_ & 63; c.wave = __builtin_amdgcn_readfirstlane(t_ >> 6); \
        { int g_ = gridDim.x; asm volatile("" : "+s"(g_)); c.G = g_; } c.vcu = __builtin_amdgcn_readfirstlane((int)MISCW[18]); c.cb = (c.G % 8 == 0) ? (c.vcu % (c.G / 8)) * 8 + c.vcu / (c.G / 8) : c.vcu; c.gw = c.vcu * NWAVES + c.wave; c.NGW = c.G * NWAVES; } \
    unsigned char* ws = aa.ws; asm volatile("" : "+s"(ws)); const unsigned char* wl = ws + WS_W + (size_t)l * W_LAYER; const float* xin = l == 0 ? aa.in[0] : aa.out; const size_t r0 = (size_t)hb * TH; (void)wl; (void)xin; (void)r0;
#define HN ((bf16*)(ws + WS_HN))
#define PROJ ((bf16*)(ws + WS_PROJ))
#define GATES (ws + WS_GATES)
#define VTC ((bf16*)(ws + WS_VTC))
#define VTD ((bf16*)(ws + WS_VTD))
#define XC ((bf16*)(ws + WS_XC))
#define YB PROJ
#define LA ((bf16*)(ws + WS_LA))
#define MG (HN + r0 * DMODEL)
#define U ((bf16*)(ws + WS_U))
#define LSE ((float*)(ws + WS_LSE))
#define AGG ((float*)(ws + WS_AGG2))
#define CARRY ((float*)(ws + WS_CARRY))
#define YD PROJ
#define KTC ((bf16*)(ws + WS_KTC))
#define KTD ((bf16*)(ws + WS_KTD))
#define HB ((bf16*)(ws + WS_H))
#define XB ((bf16*)((unsigned char*)aa.out + 64 * MiB))
#define HN8 ((unsigned char*)aa.out)
#define RS ((float*)(ws + WS_RS))
#define XF ((bf16*)(ws + WS_LA))
    int l = 0, hb = 0;
    int step = 0;
#ifndef ENMASK
#define ENMASK 0xFFFF
#endif
#define EN(k) ((ENMASK >> (k)) & 1)
#ifndef NSYNC
#define NSYNC 1
#endif
#ifndef REPMASK
#define REPMASK 0
#endif
#define REP(k) (1 + ((REPMASK >> (k)) & 1))
#define PHASE(...) do { if (step >= a.ph_lo && step < a.ph_hi) { { MKCTX(); __VA_ARGS__; } if (step + 1 < a.ph_hi) { if (step == 0) { if (a.ph_lo < 0) grid.sync();     \
            xcd_barrier(bar); \
            if (threadIdx.x == 0) { unsigned pre = 0u; const unsigned xcc = MISCW[17]; for (unsigned j = 0; j < 16; ++j) { const unsigned cj = xb_ld((unsigned*)(a.ws + WS_CTL) + 3584 + 32 * j); pre += j < xcc ? cj : 0u; } MISCW[18] = pre + MISCW[16]; } \
            __syncthreads(); } else { for (int s_ = 0; s_ < NSYNC; ++s_) xcd_barrier(bar); } } } ++step; } while (0)
#define GEMM(EPI, g, E) do { pg8::StaticOrder S_; S_.init((g).M, (g).N, c.G, c.cb); pg8::gemm_phase<EPI, pg8::StaticOrder, true, true>(c.lds, g, S_, E); } while (0)
    PHASE({ for (int rp_ = 0; rp_ < REP(0); ++rp_) p0_prologue(c, a); rms_rows_bf16(c, a.in[0], a.in[1], HN, T, HN8, RS); });
    for (l = 0; l < 2; ++l) {
        for (hb = 0; hb < 2; ++hb) {
            PHASE({ { pg8::Gemm g{HN + r0 * DMODEL, (const bf16*)(wl + OW_IN), TH, NPROJ, DMODEL, DMODEL, DMODEL}; pg8::EpiProj E{PROJ}; GEMM(pg8::EpiProj, g, E); }
                    { int k8_ = DMODEL / 2; asm volatile("" : "+s"(k8_));     pg8::Gemm g{(const bf16*)(HN8 + r0 * DMODEL), (const bf16*)(wl + OW_G8), TH, NGATE, k8_, DMODEL / 2, DMODEL / 2}; pg8::EpiGate E{GATES, a.in[3] + l * NGATE, RS + r0, 1.0f / Q_SW};
                      pg8::StaticOrder S_; S_.init(g.M, g.N, c.G, c.cb); pg8::gemm_phase<pg8::EpiGate, pg8::StaticOrder, true, true, true>(c.lds, g, S_, E); } });
            PHASE({ if (REP(12) > 1) p3_prep<true>(c, PROJ, XC, VTC, VTD, KTC, KTD, a.in[4] + l * 128, a.in[5] + l * 2048, a.in[6] + l * 512); p3_prep<false>(c, PROJ, XC, VTC, VTD, KTC, KTD, a.in[4] + l * 128, a.in[5] + l * 2048, a.in[6] + l * 512); if (l == 0 && hb == 0) { __syncthreads(); convert_w1_i8(c, a); } });
            PHASE(if (EN(4)) { int kq_ = 128; asm volatile("" : "+s"(kq_));
                    pg8::Gemm g{XC, (const bf16*)(wl + OW_G), TH, 2048, kq_, 512, 128}; pg8::EpiLru E{XC, LA, U, a.in[8] + l * 2048, (const float*)(ws + WS_SP) + l * 1024, TH}; for (int rp_ = 0; rp_ < REP(4); ++rp_) { pg8::LruOrder S_; S_.init(g.M, g.N, c.G, c.cb); pg8::gemm_phase<pg8::EpiLru, pg8::LruOrder, true, true>(c.lds, g, S_, E); }
                    if (REP(3) > 1) p4_banded(c, PROJ, VTC, VTD, KTC, KTD, LSE, a.in[10] + l * 8, true); p4_banded(c, PROJ, VTC, VTD, KTC, KTD, LSE, a.in[10] + l * 8); });
            PHASE(for (int rp_ = 0; rp_ < REP(5); ++rp_) p5_scan1_combine(c, LA, U, AGG, PROJ, LSE, YD));
            PHASE(p5b_carry(c, AGG, CARRY));
            PHASE({ for (int rp_ = 0; rp_ < REP(6); ++rp_) p6_scan3(c, LA, U, CARRY, PROJ, YB); __syncthreads(); if (REP(7) > 1) p6_attn(c, PROJ, (char*)lds, a.in[4] + l * 128, C_BX); p6_attn(c, PROJ, (char*)lds, a.in[4] + l * 128); });
            PHASE(for (int rp_ = 0; rp_ < REP(8); ++rp_) { pg8::Gemm g{PROJ, (const bf16*)(wl + OW_PA), TH, DMODEL, 512, NPROJ, 512}; pg8::EpiBranch E{GATES, MG};
                    pg8::BranchOrder S_; S_.init(g.M, g.N, c.G, c.cb); S_.a0 = C_AQ * 2; S_.a1 = C_BX * 2; S_.a2 = C_CQ * 2; S_.a3 = C_DK * 2;
                    S_.b1 = (unsigned)(OW_PB - OW_PA); S_.b2 = (unsigned)(OW_PC - OW_PA); S_.b3 = (unsigned)(OW_PD - OW_PA);
                    pg8::gemm_phase<pg8::EpiBranch, pg8::BranchOrder, true, true>(c.lds, g, S_, E); });
        }
        hb = 0;
        PHASE({ pg8::Gemm g{HN, (const bf16*)(wl + OW_OUT), T, DMODEL, DMODEL, DMODEL, DMODEL}; pg8::EpiResidB E{l == 0 ? (const void*)a.in[0] : (const void*)XB, XB, l == 0 ? 1 : 0}; GEMM(pg8::EpiResidB, g, E); });
        PHASE(rms_rows_b2b(c, XB, a.in[16] + l * DMODEL, nullptr, T, HN8, RS));
        PHASE({ int k8_ = DMODEL / 2; asm volatile("" : "+s"(k8_)); pg8::Gemm g{(const bf16*)HN8, (const bf16*)(wl + OW_1), T, FF, k8_, DMODEL / 2, DMODEL / 2}; pg8::EpiRelu2I8 E{HB, HP, RS, (const unsigned*)(ws + WS_CTL + WS_CM_OFF) + l * FF};
                pg8::StaticOrder S_; S_.init(g.M, g.N, c.G, c.cb); pg8::gemm_phase<pg8::EpiRelu2I8, pg8::StaticOrder, true, true, true>(c.lds, g, S_, E); });
        PHASE({ pg8::Gemm g{HB, (const bf16*)(wl + OW_2), T, DMODEL, FF, HP, HP}; pg8::EpiResidB E{(const void*)XB, l == 0 ? XB : XF, 0}; GEMM(pg8::EpiResidB, g, E); });
        PHASE({ if (l == 0) rms_rows_b2b(c, XB, a.in[1] + DMODEL, HN, T, HN8, RS); else rms_final_b2f(c, XF, a.in[19], a.out, T); });
    }
#undef PHASE
#undef GEMM
}

extern "C" void kernel_launch(void* const* d_in, const int* in_sizes, int n_in, void* d_out, int out_size, void* d_ws, size_t ws_size, hipStream_t stream) {
    static int grid = 0;
    if (grid == 0) {
        if (n_in != 20 || out_size != T * DMODEL || ws_size < WS_END) { fprintf(stderr, "kernel_launch: unexpected shapes (n_in %d out %d ws %zu)\n", n_in, out_size, ws_size); grid = -1; return; }
        int dev = 0, cus = 0, per_cu = 0;
        if (hipGetDevice(&dev) != hipSuccess || hipDeviceGetAttribute(&cus, hipDeviceAttributeMultiprocessorCount, dev) != hipSuccess) { grid = -1; return; }
        if (hipFuncSetAttribute((const void*)fwd, hipFuncAttributeMaxDynamicSharedMemorySize, LDS_BYTES) != hipSuccess) { fprintf(stderr, "hipFuncSetAttribute failed\n"); grid = -1; return; }
        if (hipOccupancyMaxActiveBlocksPerMultiprocessor(&per_cu, (const void*)fwd, NTHREADS, LDS_BYTES) != hipSuccess || per_cu < 1) per_cu = 1;
        if (per_cu > 1) per_cu = 1;
        (void)hipGetLastError();
        grid = cus * per_cu;
        fprintf(stderr, "kernel_launch: grid %d (cus %d x %d) ws %zu\n", grid, cus, per_cu, ws_size);
    }
    if (grid < 0) return;
    if (hipMemsetAsync((char*)d_ws + WS_CTL, 0, CTL_ZERO_BYTES, stream) != hipSuccess) { fprintf(stderr, "kernel_launch: memset failed\n"); return; }
    Args a{};
    for (int i = 0; i < 20; ++i) a.in[i] = (const float*)d_in[i];
    a.out = (float*)d_out; a.ws = (unsigned char*)d_ws;
#if defined(MK_MULTI) && MK_MULTI
    for (int s = 0; s < NSTEPS; ++s) { a.ph_lo = s; a.ph_hi = s + 1; hipLaunchKernelGGL(fwd, dim3(grid), dim3(NTHREADS), LDS_BYTES, stream, a); }
#else
    a.ph_lo = 0; a.ph_hi = NSTEPS;
    void* args[] = {&a};
    const hipError_t e = hipLaunchCooperativeKernel((const void*)fwd, dim3(grid), dim3(NTHREADS), args, LDS_BYTES, stream);
    if (e != hipSuccess) fprintf(stderr, "kernel_launch: cooperative launch failed: %s (grid %d)\n", hipGetErrorString(e), grid);
#endif
}
```

```cpp
#include <hip/hip_runtime.h>
#include <hip/hip_cooperative_groups.h>
#include <hip/hip_bf16.h>
#include <cstdio>
#include <cstdint>
#include <cmath>
namespace cg = cooperative_groups;
namespace pg8 {
#define PG8_LAS __attribute__((address_space(3)))
typedef unsigned short bf16_t;
typedef short bf16x8 __attribute__((ext_vector_type(8)));
typedef float f32x4 __attribute__((ext_vector_type(4)));
typedef unsigned u32x4 __attribute__((ext_vector_type(4)));
constexpr int BM = 256, BK = 64, HALF = 128, HTB = HALF * BK * 2  , STAGE_BYTES = 8 * HTB, NXCD = 8, WGM = 8;

__host__ __device__ __forceinline__ int lds_byte(int r, int c) { const int st = (r >> 4) * 2 + (c >> 5), rr = r & 15, cc = c & 31, ob = rr * 64 + cc * 2; return st * 1024 + (ob ^ (((ob >> 9) & 1) << 5)); }
__host__ __device__ __forceinline__ void stage_rc(int b, int& R, int& C) { const int st = b / 1024, sb = b % 1024, swz = sb ^ (((sb >> 9) & 1) << 5); R = (st >> 1) * 16 + swz / 64; C = (st & 1) * 32 + (swz % 64) / 2; }
__host__ __device__ __forceinline__ int perm32(int rho) { const int n = rho >> 4, i = rho & 15; return 8 * (i >> 2) + 4 * n + (i & 3); }

struct Unit { int pm, pn, br; };
struct Gemm { const bf16_t* A; const bf16_t* Bt; int M, N, K, lda, ldb; };

struct StaticOrder {
    int nM, nN, nwg, G, c;
    __host__ __device__ void init(int M, int N, int G_, int c_) { nM = M / BM; nN = N / BM; nwg = nM * nN; G = G_; c = c_; }
    __host__ __device__ bool next(int i, Unit& u) const {
        const long L = (long)i * G + c; if (L >= nwg) return false;
        int wgid = (int)L; { const int q = nwg / NXCD, r = nwg % NXCD, xcd = wgid % NXCD, off = wgid / NXCD; wgid = (xcd < r ? xcd * (q + 1) : r * (q + 1) + (xcd - r) * q) + off; }
        const int nig = WGM * nN, gid = wgid / nig, fm = gid * WGM, gsz = (nM - fm) < WGM ? (nM - fm) : WGM;
        u.pm = fm + ((wgid % nig) % gsz); u.pn = (wgid % nig) / gsz; u.br = 0; return true;
    }
    __device__ __forceinline__ void a_ready(const Unit&) const {}
    __device__ __forceinline__ void done(const Unit&) const {}
    __device__ __forceinline__ size_t aoff(const Unit&) const { return 0; }
    __device__ __forceinline__ size_t boff(const Unit&) const { return 0; }
    __device__ __forceinline__ int ntiles(const Unit&, int K) const { return K / BK; }
};
struct LruOrder : StaticOrder {
    __device__ __forceinline__ size_t aoff(const Unit& u) const { return (size_t)(u.pn & 3) * 256; }
};
struct BranchOrder : StaticOrder {
    unsigned a0, a1, a2, a3, b1, b2, b3;
    __host__ __device__ bool next(int i, Unit& u) const { const bool ok = StaticOrder::next(i >> 2, u); u.br = i & 3; return ok; }
    __device__ __forceinline__ size_t aoff(const Unit& u) const { return u.br == 0 ? a0 : u.br == 1 ? a1 : u.br == 2 ? a2 : a3; }
    __device__ __forceinline__ size_t boff(const Unit& u) const { return u.br == 0 ? 0u : u.br == 1 ? b1 : u.br == 2 ? b2 : b3; }
    __device__ __forceinline__ int ntiles(const Unit& u, int) const { return u.br == 3 ? 4 : 8; }
};

__device__ __forceinline__ unsigned cvt_pk_bf16(float lo, float hi) { unsigned r; asm volatile("v_cvt_pk_bf16_f32 %0, %1, %2" : "=v"(r) : "v"(lo), "v"(hi)); return r; }
typedef float f32x2 __attribute__((ext_vector_type(2)));
__device__ __forceinline__ float sigm(float x) { return __builtin_amdgcn_rcpf(1.f + __builtin_amdgcn_exp2f(-1.4426950408889634f * x)); }
__device__ __forceinline__ float sg2(float z2) { return __builtin_amdgcn_rcpf(1.f + __builtin_amdgcn_exp2f(z2)); }
__device__ __forceinline__ float bflo(unsigned w) { return __uint_as_float(w << 16); }
__device__ __forceinline__ float bfhi(unsigned w) { return __uint_as_float(w & 0xffff0000u); }
typedef unsigned u32x2 __attribute__((ext_vector_type(2)));
constexpr int NPROJ = 4864, NGATE = 4096, NGT0 = NPROJ / 256;

struct EpiProj {
    static constexpr bool PERM = true, AFTER_DRAIN = false, PREFETCH = false;
    bf16_t* P;
    __device__ __forceinline__ void operator()(const f32x4 (&acc)[2][2][4][2], const Unit& u, int wr, int wc, int fr, int fq) const {
        const int row0 = u.pm * BM + wr * 64 + fr; const int col0 = u.pn * BM + wc * 32 + 8 * fq;
#pragma unroll
        for (int ai = 0; ai < 2; ++ai)
#pragma unroll
            for (int m = 0; m < 4; ++m) { bf16_t* rowp = P + (size_t)(row0 + ai * HALF + m * 16) * NPROJ + col0;
#pragma unroll
                for (int bj = 0; bj < 2; ++bj) { const f32x4 v0 = acc[ai][bj][m][0], v1 = acc[ai][bj][m][1];
                    u32x4 w; w.x = cvt_pk_bf16(v0[0], v0[1]); w.y = cvt_pk_bf16(v0[2], v0[3]); w.z = cvt_pk_bf16(v1[0], v1[1]); w.w = cvt_pk_bf16(v1[2], v1[3]);
                    *(u32x4*)(rowp + bj * HALF) = w; } }
    }
};
struct EpiGate {
    static constexpr bool PERM = true, AFTER_DRAIN = false, PREFETCH = true;
    unsigned char* Gt; const float* gbias; const float* rs; float sc; bf16_t* P;
    __device__ __forceinline__ void prefetch(const Unit& u, int wr, int fr, float (&pre)[8]) const {
#pragma unroll
        for (int i = 0; i < 8; ++i) pre[i] = rs[u.pm * BM + wr * 64 + fr + (i >> 2) * HALF + (i & 3) * 16];
    }
    __device__ __forceinline__ void operator()(const f32x4 (&acc)[2][2][4][2], const Unit& u, int wr, int wc, int fr, int fq, const float (&pre)[8]) const {
        typedef int v4i_ __attribute__((ext_vector_type(4)));
        const int row0 = u.pm * BM + wr * 64 + fr; const int g0 = u.pn * BM + wc * 32 + 8 * fq;
        if (u.pn >= 16) {
#pragma unroll
            for (int ai = 0; ai < 2; ++ai)
#pragma unroll
                for (int m = 0; m < 4; ++m) { bf16_t* rowp = P + (size_t)(row0 + ai * HALF + m * 16) * NPROJ + g0; const float f = pre[ai * 4 + m] * sc;
#pragma unroll
                    for (int bj = 0; bj < 2; ++bj) { const v4i_ i0 = __builtin_bit_cast(v4i_, acc[ai][bj][m][0]), i1 = __builtin_bit_cast(v4i_, acc[ai][bj][m][1]);
                        u32x4 w; w.x = cvt_pk_bf16((float)i0[0] * f, (float)i0[1] * f); w.y = cvt_pk_bf16((float)i0[2] * f, (float)i0[3] * f); w.z = cvt_pk_bf16((float)i1[0] * f, (float)i1[1] * f); w.w = cvt_pk_bf16((float)i1[2] * f, (float)i1[3] * f);
                        *(u32x4*)(rowp + bj * HALF) = w; } }
            return; }
        f32x4 bv[2][2];
#pragma unroll
        for (int bj = 0; bj < 2; ++bj)
#pragma unroll
            for (int n = 0; n < 2; ++n) bv[bj][n] = *(const f32x4*)(gbias + g0 + bj * HALF + 4 * n) * -1.4426950408889634f;
#pragma unroll
        for (int ai = 0; ai < 2; ++ai)
#pragma unroll
            for (int m = 0; m < 4; ++m) { unsigned char* rowp = Gt + (size_t)(row0 + ai * HALF + m * 16) * NGATE + g0; const float scr_ = pre[ai * 4 + m] * sc * -1.4426950408889634f;
#pragma unroll
                for (int bj = 0; bj < 2; ++bj) { const v4i_ i0 = __builtin_bit_cast(v4i_, acc[ai][bj][m][0]), i1 = __builtin_bit_cast(v4i_, acc[ai][bj][m][1]);
                    const f32x4 v0 = (f32x4){(float)i0[0], (float)i0[1], (float)i0[2], (float)i0[3]} * scr_ + bv[bj][0], v1 = (f32x4){(float)i1[0], (float)i1[1], (float)i1[2], (float)i1[3]} * scr_ + bv[bj][1];
                    u32x2 w;
                    w.x = (unsigned)(sg2(v0[0]) * 255.f + 0.5f) | ((unsigned)(sg2(v0[1]) * 255.f + 0.5f) << 8) | ((unsigned)(sg2(v0[2]) * 255.f + 0.5f) << 16) | ((unsigned)(sg2(v0[3]) * 255.f + 0.5f) << 24);
                    w.y = (unsigned)(sg2(v1[0]) * 255.f + 0.5f) | ((unsigned)(sg2(v1[1]) * 255.f + 0.5f) << 8) | ((unsigned)(sg2(v1[2]) * 255.f + 0.5f) << 16) | ((unsigned)(sg2(v1[3]) * 255.f + 0.5f) << 24);
                    *(u32x2*)(rowp + bj * HALF) = w; } }
    }
};

struct EpiLru {
    static constexpr bool PERM = false, AFTER_DRAIN = false, PREFETCH = false;
    const bf16_t* XC; bf16_t* LA; bf16_t* U; const float* gb; const float* sp8; int TH;
    __device__ __forceinline__ void operator()(const f32x4 (&acc)[2][2][4][2], const Unit& u, int wr, int wc, int fr, int fq) const {
        const int d = u.pn >> 2, cb = u.pn & 3; const int row0 = u.pm * BM + wr * 64 + fr;
#pragma unroll
        for (int n = 0; n < 2; ++n) { const int c0 = cb * 128 + wc * 32 + n * 16 + 4 * fq;
            const f32x4 br = *(const f32x4*)(gb + (d * 2 + 0) * 512 + c0), bi = *(const f32x4*)(gb + (d * 2 + 1) * 512 + c0), sp = *(const f32x4*)(sp8 + d * 512 + c0);
            u32x2 xws[2][4];
#pragma unroll
            for (int ai = 0; ai < 2; ++ai)
#pragma unroll
                for (int m = 0; m < 4; ++m) xws[ai][m] = *(const u32x2*)(XC + (size_t)(row0 + ai * HALF + m * 16) * 512 + c0);
#pragma unroll
            for (int ai = 0; ai < 2; ++ai)
#pragma unroll
                for (int m = 0; m < 4; ++m) { const size_t row = (size_t)(row0 + ai * HALF + m * 16);
                    const u32x2 xw = xws[ai][m];
                    const float xv[4] = {bflo(xw.x), bfhi(xw.x), bflo(xw.y), bfhi(xw.y)};
                    float la[4], uu[4];
#pragma unroll
                    for (int e = 0; e < 4; ++e) { const float r = sigm(acc[ai][0][m][n][e] + br[e]), ig = sigm(acc[ai][1][m][n][e] + bi[e]);
                        const float l = -sp[e] * r, y = 2.f * l; la[e] = l * 1.4426950408889634f;
                        const float ser = -y * (1.f + y * (0.5f + y * (0.16666667f + y * (0.041666668f + y * 0.0083333338f))));
                        const float dir = 1.f - __builtin_amdgcn_exp2f(y * 1.4426950408889634f);
                        uu[e] = __builtin_amdgcn_sqrtf(y > -0.25f ? ser : dir) * (ig * xv[e]); }
                    u32x2 w0, w1; w0.x = cvt_pk_bf16(la[0], la[1]); w0.y = cvt_pk_bf16(la[2], la[3]); w1.x = cvt_pk_bf16(uu[0], uu[1]); w1.y = cvt_pk_bf16(uu[2], uu[3]);
                    *(u32x2*)(LA + ((size_t)d * TH + row) * 512 + c0) = w0; *(u32x2*)(U + ((size_t)d * TH + row) * 512 + c0) = w1; } }
    }
};

template <bool FIRST> struct EpiBranchT {
    static constexpr bool PERM = true, AFTER_DRAIN = false, PREFETCH = false;
    const unsigned char* Gt; bf16_t* Mg;
    __device__ __forceinline__ void operator()(const f32x4 (&acc)[2][2][4][2], const Unit& u, int wr, int wc, int fr, int fq) const {
        const int row0 = u.pm * BM + wr * 64 + fr; const int col0 = u.pn * BM + wc * 32 + 8 * fq; const float k = 1.0f / 255.0f;
        u32x2 gqs[2][4][2];
#pragma unroll
        for (int ai = 0; ai < 2; ++ai)
#pragma unroll
            for (int m = 0; m < 4; ++m)
#pragma unroll
                for (int bj = 0; bj < 2; ++bj) gqs[ai][m][bj] = *(const u32x2*)(Gt + (size_t)(row0 + ai * HALF + m * 16) * NGATE + col0 + bj * HALF);
#pragma unroll
        for (int ai = 0; ai < 2; ++ai)
#pragma unroll
            for (int m = 0; m < 4; ++m) { const size_t row = (size_t)(row0 + ai * HALF + m * 16);
#pragma unroll
                for (int bj = 0; bj < 2; ++bj) { const int col = col0 + bj * HALF;
                    const u32x2 gq = gqs[ai][m][bj];
                    f32x4 v0 = acc[ai][bj][m][0], v1 = acc[ai][bj][m][1];
                    v0[0] *= (float)(gq.x & 255u) * k; v0[1] *= (float)((gq.x >> 8) & 255u) * k; v0[2] *= (float)((gq.x >> 16) & 255u) * k; v0[3] *= (float)(gq.x >> 24) * k;
                    v1[0] *= (float)(gq.y & 255u) * k; v1[1] *= (float)((gq.y >> 8) & 255u) * k; v1[2] *= (float)((gq.y >> 16) & 255u) * k; v1[3] *= (float)(gq.y >> 24) * k;
                    bf16_t* p = Mg + row * 1024 + col;
                    if (!FIRST) { const u32x4 o = *(const u32x4*)p;
                        v0[0] += bflo(o.x); v0[1] += bfhi(o.x); v0[2] += bflo(o.y); v0[3] += bfhi(o.y); v1[0] += bflo(o.z); v1[1] += bfhi(o.z); v1[2] += bflo(o.w); v1[3] += bfhi(o.w); }
                    u32x4 w; w.x = cvt_pk_bf16(v0[0], v0[1]); w.y = cvt_pk_bf16(v0[2], v0[3]); w.z = cvt_pk_bf16(v1[0], v1[1]); w.w = cvt_pk_bf16(v1[2], v1[3]);
                    *(u32x4*)p = w; }
                if (m & 1) asm volatile("" ::: "memory"); }
    }
};

struct EpiBranch {
    static constexpr bool PERM = true, AFTER_DRAIN = false, PREFETCH = false;
    const unsigned char* Gt; bf16_t* Mg;
    __device__ __forceinline__ void operator()(const f32x4 (&acc)[2][2][4][2], const Unit& u, int wr, int wc, int fr, int fq) const {
        if (u.br == 0) { EpiBranchT<true> e{Gt, Mg}; e(acc, u, wr, wc, fr, fq); } else { EpiBranchT<false> e{Gt + u.br * 1024, Mg}; e(acc, u, wr, wc, fr, fq); }
    }
};

struct EpiResid {
    static constexpr bool PERM = false, AFTER_DRAIN = false, PREFETCH = false;
    const float* base; float* out;
    __device__ __forceinline__ void operator()(const f32x4 (&acc)[2][2][4][2], const Unit& u, int wr, int wc, int fr, int fq) const {
        const int row0 = u.pm * BM + wr * 64 + fr; const int col0 = u.pn * BM + wc * 32 + 4 * fq;
#pragma unroll
        for (int ai = 0; ai < 2; ++ai)
#pragma unroll
            for (int m = 0; m < 4; ++m) { const size_t off = (size_t)(row0 + ai * HALF + m * 16) * 1024 + col0;
#pragma unroll
                for (int bj = 0; bj < 2; ++bj)
#pragma unroll
                    for (int n = 0; n < 2; ++n) { const size_t o = off + bj * HALF + n * 16; *(f32x4*)(out + o) = *(const f32x4*)(base + o) + acc[ai][bj][m][n]; } }
    }
};

struct EpiRelu2 {
    static constexpr bool PERM = true, AFTER_DRAIN = false, PREFETCH = false;
    bf16_t* H; int ldh;
    __device__ __forceinline__ void operator()(const f32x4 (&acc)[2][2][4][2], const Unit& u, int wr, int wc, int fr, int fq) const {
        const int row0 = u.pm * BM + wr * 64 + fr; const int col0 = u.pn * BM + wc * 32 + 8 * fq;
#pragma unroll
        for (int ai = 0; ai < 2; ++ai)
#pragma unroll
            for (int m = 0; m < 4; ++m) { bf16_t* rowp = H + (size_t)(row0 + ai * HALF + m * 16) * ldh + col0;
#pragma unroll
                for (int bj = 0; bj < 2; ++bj) { f32x4 v0 = acc[ai][bj][m][0], v1 = acc[ai][bj][m][1];
#pragma unroll
                    for (int e = 0; e < 4; ++e) { const float a = fmaxf(v0[e], 0.f), b = fmaxf(v1[e], 0.f); v0[e] = a * a; v1[e] = b * b; }
                    u32x4 w; w.x = cvt_pk_bf16(v0[0], v0[1]); w.y = cvt_pk_bf16(v0[2], v0[3]); w.z = cvt_pk_bf16(v1[0], v1[1]); w.w = cvt_pk_bf16(v1[2], v1[3]);
                    *(u32x4*)(rowp + bj * HALF) = w; } }
    }
};

struct EpiResidB {
    static constexpr bool PERM = true, AFTER_DRAIN = false, PREFETCH = false;
    const void* base; bf16_t* out; int base_f32;
    __device__ __forceinline__ void operator()(const f32x4 (&acc)[2][2][4][2], const Unit& u, int wr, int wc, int fr, int fq) const {
        const int row0 = u.pm * BM + wr * 64 + fr; const int col0 = u.pn * BM + wc * 32 + 8 * fq;
#pragma unroll
        for (int ai = 0; ai < 2; ++ai)
#pragma unroll
            for (int m = 0; m < 4; ++m) { const size_t off = (size_t)(row0 + ai * HALF + m * 16) * 1024 + col0;
#pragma unroll
                for (int bj = 0; bj < 2; ++bj) { const size_t o = off + bj * HALF; f32x4 v0 = acc[ai][bj][m][0], v1 = acc[ai][bj][m][1];
                    if (base_f32) { v0 += *(const f32x4*)((const float*)base + o); v1 += *(const f32x4*)((const float*)base + o + 4); }
                    else { const u32x4 b = *(const u32x4*)((const bf16_t*)base + o); v0[0] += bflo(b.x); v0[1] += bfhi(b.x); v0[2] += bflo(b.y); v0[3] += bfhi(b.y); v1[0] += bflo(b.z); v1[1] += bfhi(b.z); v1[2] += bflo(b.w); v1[3] += bfhi(b.w); }
                    u32x4 w; w.x = cvt_pk_bf16(v0[0], v0[1]); w.y = cvt_pk_bf16(v0[2], v0[3]); w.z = cvt_pk_bf16(v1[0], v1[1]); w.w = cvt_pk_bf16(v1[2], v1[3]);
                    *(u32x4*)(out + o) = w; } }
    }
};

struct EpiRelu2I8 {
    static constexpr bool PERM = true, AFTER_DRAIN = false, PREFETCH = true;
    bf16_t* H; int ldh; const float* rs; const unsigned* cm;
    __device__ __forceinline__ void prefetch(const Unit& u, int wr, int fr, float (&pre)[8]) const {
#pragma unroll
        for (int i = 0; i < 8; ++i) pre[i] = rs[u.pm * BM + wr * 64 + fr + (i >> 2) * HALF + (i & 3) * 16];
    }
    __device__ __forceinline__ void operator()(const f32x4 (&acc)[2][2][4][2], const Unit& u, int wr, int wc, int fr, int fq, const float (&pre)[8]) const {
        typedef int v4i_ __attribute__((ext_vector_type(4)));
        const int row0 = u.pm * BM + wr * 64 + fr; const int col0 = u.pn * BM + wc * 32 + 8 * fq;
        f32x4 cs[2][2];
#pragma unroll
        for (int bj = 0; bj < 2; ++bj)
#pragma unroll
            for (int n = 0; n < 2; ++n) { const u32x4 t = *(const u32x4*)(cm + col0 + bj * HALF + 4 * n); cs[bj][n] = (f32x4){__uint_as_float(t.x), __uint_as_float(t.y), __uint_as_float(t.z), __uint_as_float(t.w)} * (1.0f / 127.0f); }
#pragma unroll
        for (int ai = 0; ai < 2; ++ai)
#pragma unroll
            for (int m = 0; m < 4; ++m) { bf16_t* rowp = H + (size_t)(row0 + ai * HALF + m * 16) * ldh + col0; const float f = pre[ai * 4 + m];
#pragma unroll
                for (int bj = 0; bj < 2; ++bj) { const v4i_ i0 = __builtin_bit_cast(v4i_, acc[ai][bj][m][0]), i1 = __builtin_bit_cast(v4i_, acc[ai][bj][m][1]); f32x4 v0, v1;
#pragma unroll
                    for (int e = 0; e < 4; ++e) { const float a = fmaxf((float)i0[e], 0.f) * (f * cs[bj][0][e]), b = fmaxf((float)i1[e], 0.f) * (f * cs[bj][1][e]); v0[e] = a * a; v1[e] = b * b; }
                    u32x4 w; w.x = cvt_pk_bf16(v0[0], v0[1]); w.y = cvt_pk_bf16(v0[2], v0[3]); w.z = cvt_pk_bf16(v1[0], v1[1]); w.w = cvt_pk_bf16(v1[2], v1[3]);
                    *(u32x4*)(rowp + bj * HALF) = w; } }
    }
};
template <class Epi, class Sched, bool ALIGN_EPI = false, bool SP2 = false, bool I8 = false>
__device__ __forceinline__ void gemm_phase(PG8_LAS unsigned char* lds, const Gemm g, const Sched& S, const Epi& E) {
    int tid_ = threadIdx.x; asm volatile("" : "+v"(tid_));
    const int tid = tid_, wid = __builtin_amdgcn_readfirstlane(tid >> 6), lane = tid & 63, wr = wid >> 2, wc = wid & 3, fr = lane & 15, fq = lane >> 4;
    const int K = g.K; int nt = K / BK;
    unsigned voffA[2], voffB[2];
#pragma unroll
    for (int i = 0; i < 2; ++i) { int R, C; stage_rc(tid * 16 + i * 8192, R, C); const int Rb = Epi::PERM ? ((R & ~31) + perm32(R & 31)) : R;
        voffA[i] = (unsigned)(R * g.lda + C) * 2u; voffB[i] = (unsigned)(Rb * g.ldb + C) * 2u; }
    const size_t kstep = (size_t)(BK * 2);
    const size_t hstepA = (size_t)HALF * g.lda * 2, hstepB = (size_t)HALF * g.ldb * 2;
    const size_t tstepA = 2 * hstepA, tstepB = 2 * hstepB;
    const unsigned ldsw = (unsigned)wid * 1024u;
    const int aoff = lds_byte(wr * 64 + fr, fq * 8), boff = lds_byte(wc * 32 + fr, fq * 8);
#define PG8_SA(b, h) (((b) * 2 + (h)) * HTB)
#define PG8_SB(b, h) ((4 + (b) * 2 + (h)) * HTB)
#define PG8_STAGE(bufoff, gbase, voff) do { _Pragma("unroll") for (int _i = 0; _i < 2; ++_i) \
        __builtin_amdgcn_global_load_lds((const unsigned*)((const char*)(gbase) + (voff)[_i]), (PG8_LAS unsigned*)(lds + (bufoff) + ldsw + _i * 8192), 16, 0, 0); } while (0)
#define PG8_LDA(dst, b, h) do { _Pragma("unroll") for (int m = 0; m < 4; ++m) _Pragma("unroll") for (int k = 0; k < 2; ++k) dst[m][k] = *(const PG8_LAS bf16x8*)(lds + PG8_SA(b, h) + aoff + m * 2048 + k * 1024); } while (0)
#define PG8_LDB(dst, b, h) do { _Pragma("unroll") for (int n = 0; n < 2; ++n) _Pragma("unroll") for (int k = 0; k < 2; ++k) dst[n][k] = *(const PG8_LAS bf16x8*)(lds + PG8_SB(b, h) + boff + n * 2048 + k * 1024); } while (0)
#define PG8_MMA(ai, bj, At, Bt) do { __builtin_amdgcn_s_setprio(1); _Pragma("unroll") for (int m = 0; m < 4; ++m) _Pragma("unroll") for (int n = 0; n < 2; ++n) _Pragma("unroll") for (int k = 0; k < 2; ++k) { \
        if constexpr (I8) { typedef int v4i_ __attribute__((ext_vector_type(4))); \
            acc[ai][bj][m][n] = __builtin_bit_cast(f32x4, __builtin_amdgcn_mfma_i32_16x16x64_i8(__builtin_bit_cast(v4i_, Bt[n][k]), __builtin_bit_cast(v4i_, At[m][k]), __builtin_bit_cast(v4i_, acc[ai][bj][m][n]), 0, 0, 0)); } \
        else acc[ai][bj][m][n] = __builtin_amdgcn_mfma_f32_16x16x32_bf16(Bt[n][k], At[m][k], acc[ai][bj][m][n], 0, 0, 0); } \
        __builtin_amdgcn_s_setprio(0); } while (0)
#define PG8_WAIT_V(n) asm volatile("s_waitcnt vmcnt(" #n ")" ::: "memory")
#define PG8_WAIT_L(n) asm volatile("s_waitcnt lgkmcnt(" #n ")" ::: "memory")
#define PG8_BAR __builtin_amdgcn_s_barrier()
#define PG8_SCHED __builtin_amdgcn_sched_barrier(0)
    Unit cur, nxt; int ui = 0;
    if (!S.next(0, cur)) return;
    float epre[8];
    f32x4 acc[2][2][4][2];
#pragma unroll
    for (int a = 0; a < 2; ++a)
#pragma unroll
        for (int b = 0; b < 2; ++b)
#pragma unroll
            for (int m = 0; m < 4; ++m)
#pragma unroll
                for (int n = 0; n < 2; ++n) acc[a][b][m][n] = (f32x4){0.f, 0.f, 0.f, 0.f};
    bf16x8 At[4][2], B0[2][2], B1[2][2];
    const char* cA = (const char*)g.A + (size_t)cur.pm * tstepA + S.aoff(cur); const char* cB = (const char*)g.Bt + (size_t)cur.pn * tstepB + S.boff(cur); nt = S.ntiles(cur, K);
    S.a_ready(cur);
    if constexpr (SP2) {
        PG8_STAGE(PG8_SB(0, 0), cB, voffB); PG8_STAGE(PG8_SB(0, 1), cB + hstepB, voffB); PG8_STAGE(PG8_SA(0, 0), cA, voffA); PG8_STAGE(PG8_SA(0, 1), cA + hstepA, voffA);
        if (wr == 1) PG8_BAR;
        PG8_WAIT_V(2); PG8_BAR;
        PG8_STAGE(PG8_SB(1, 0), cB + kstep, voffB); PG8_STAGE(PG8_SA(1, 0), cA + kstep, voffA); PG8_STAGE(PG8_SB(1, 1), cB + hstepB + kstep, voffB);
        PG8_WAIT_V(6); PG8_BAR;
    } else {
        PG8_STAGE(PG8_SB(0, 0), cB, voffB); PG8_STAGE(PG8_SA(0, 0), cA, voffA); PG8_STAGE(PG8_SB(0, 1), cB + hstepB, voffB); PG8_STAGE(PG8_SA(0, 1), cA + hstepA, voffA);
        if (wr == 1) PG8_BAR;
        PG8_WAIT_V(4); PG8_BAR;
        PG8_STAGE(PG8_SB(1, 0), cB + kstep, voffB); PG8_STAGE(PG8_SA(1, 0), cA + kstep, voffA); PG8_STAGE(PG8_SB(1, 1), cB + hstepB + kstep, voffB);
        PG8_WAIT_V(6); PG8_BAR;
    }
    for (;;) {
        const bool has_next = S.next(ui + 1, nxt);
        const char* nA = has_next ? (const char*)g.A + (size_t)nxt.pm * tstepA + S.aoff(nxt) : cA; const char* nB = has_next ? (const char*)g.Bt + (size_t)nxt.pn * tstepB + S.boff(nxt) : cB;
        for (int t = 0; t < nt; t += 2) {
            const bool last = (t == nt - 2);
            const char* a1 = cA + (size_t)(t + 1) * kstep;
            const char* a2 = last ? nA : cA + (size_t)(t + 2) * kstep; const char* b2 = last ? nB : cB + (size_t)(t + 2) * kstep;
            const char* a3 = a2 + kstep; const char* b3 = b2 + kstep;
            if (last && has_next) S.a_ready(nxt);
            if constexpr (Epi::PREFETCH) { if (last) E.prefetch(cur, wr, fr, epre); }
            if constexpr (SP2) {
            PG8_LDB(B0, 0, 0); PG8_LDB(B1, 0, 1); PG8_SCHED; PG8_LDA(At, 0, 0); PG8_STAGE(PG8_SA(1, 1), a1 + hstepA, voffA);
            PG8_WAIT_V(8); PG8_WAIT_L(0); PG8_BAR; PG8_MMA(0, 0, At, B0); PG8_MMA(0, 1, At, B1); PG8_BAR; PG8_SCHED;
            PG8_LDA(At, 0, 1); PG8_STAGE(PG8_SB(0, 0), b2, voffB); PG8_STAGE(PG8_SB(0, 1), b2 + hstepB, voffB); PG8_STAGE(PG8_SA(0, 0), a2, voffA);
            PG8_WAIT_V(8); PG8_WAIT_L(0); PG8_BAR; PG8_MMA(1, 0, At, B0); PG8_MMA(1, 1, At, B1); PG8_BAR; PG8_SCHED;
            PG8_LDB(B0, 1, 0); PG8_LDB(B1, 1, 1); PG8_SCHED; PG8_LDA(At, 1, 0); PG8_STAGE(PG8_SA(0, 1), a2 + hstepA, voffA);
            PG8_WAIT_V(8); PG8_WAIT_L(0); PG8_BAR; PG8_MMA(0, 0, At, B0); PG8_MMA(0, 1, At, B1); PG8_BAR; PG8_SCHED;
            PG8_LDA(At, 1, 1); PG8_STAGE(PG8_SB(1, 0), b3, voffB); PG8_STAGE(PG8_SB(1, 1), b3 + hstepB, voffB); PG8_STAGE(PG8_SA(1, 0), a3, voffA);
            PG8_WAIT_V(8); PG8_WAIT_L(0); PG8_BAR; PG8_MMA(1, 0, At, B0); PG8_MMA(1, 1, At, B1); PG8_BAR; PG8_SCHED;
            } else {
            PG8_LDB(B0, 0, 0); PG8_SCHED; PG8_LDA(At, 0, 0); PG8_STAGE(PG8_SA(1, 1), a1 + hstepA, voffA);
            PG8_WAIT_L(8); PG8_BAR; PG8_WAIT_L(0); PG8_MMA(0, 0, At, B0); PG8_BAR; PG8_SCHED;
            PG8_LDB(B1, 0, 1); PG8_STAGE(PG8_SB(0, 0), b2, voffB);
            PG8_BAR; PG8_WAIT_L(0); PG8_MMA(0, 1, At, B1); PG8_BAR;
            PG8_LDA(At, 0, 1); PG8_STAGE(PG8_SA(0, 0), a2, voffA);
            PG8_BAR; PG8_WAIT_L(0); PG8_MMA(1, 0, At, B0); PG8_BAR; PG8_SCHED;
            PG8_STAGE(PG8_SB(0, 1), b2 + hstepB, voffB);
            PG8_WAIT_V(6); PG8_BAR; PG8_MMA(1, 1, At, B1); PG8_BAR;
            PG8_LDB(B0, 1, 0); PG8_SCHED; PG8_LDA(At, 1, 0); PG8_STAGE(PG8_SA(0, 1), a2 + hstepA, voffA);
            PG8_WAIT_L(8); PG8_BAR; PG8_WAIT_L(0); PG8_MMA(0, 0, At, B0); PG8_BAR; PG8_SCHED;
            PG8_LDB(B1, 1, 1); PG8_STAGE(PG8_SB(1, 0), b3, voffB);
            PG8_BAR; PG8_WAIT_L(0); PG8_MMA(0, 1, At, B1); PG8_BAR;
            PG8_LDA(At, 1, 1); PG8_STAGE(PG8_SA(1, 0), a3, voffA);
            PG8_BAR; PG8_WAIT_L(0); PG8_MMA(1, 0, At, B0); PG8_BAR; PG8_SCHED;
            PG8_STAGE(PG8_SB(1, 1), b3 + hstepB, voffB);
            PG8_WAIT_V(6); PG8_BAR; PG8_MMA(1, 1, At, B1); PG8_BAR;
            }
        }
        if constexpr (ALIGN_EPI) { if (wr == 0) PG8_BAR; }
        if constexpr (!Epi::AFTER_DRAIN) { if constexpr (Epi::PREFETCH) E(acc, cur, wr, wc, fr, fq, epre); else E(acc, cur, wr, wc, fr, fq); S.done(cur); }
        if (!has_next) break;
#pragma unroll
        for (int a = 0; a < 2; ++a)
#pragma unroll
            for (int b = 0; b < 2; ++b)
#pragma unroll
                for (int m = 0; m < 4; ++m)
#pragma unroll
                    for (int n = 0; n < 2; ++n) acc[a][b][m][n] = (f32x4){0.f, 0.f, 0.f, 0.f};
        cur = nxt; cA = nA; cB = nB; ++ui; nt = S.ntiles(cur, K);
        if constexpr (ALIGN_EPI) { if (wr == 1) PG8_BAR; }
    }
    PG8_WAIT_V(0);
    if constexpr (!ALIGN_EPI) { if (wr == 0) PG8_BAR; }
    PG8_BAR;
    if constexpr (Epi::AFTER_DRAIN) { E.fused(acc, cur, wr, wc, fr, fq, lds, wid, lane); S.done(cur); }
#undef PG8_SA
#undef PG8_SB
#undef PG8_STAGE
#undef PG8_LDA
#undef PG8_LDB
#undef PG8_MMA
#undef PG8_WAIT_V
#undef PG8_WAIT_L
#undef PG8_BAR
#undef PG8_SCHED
}
}
namespace attn_body {
using bf16=__hip_bfloat16;
using bf16x8=__attribute__((ext_vector_type(8)))short;
using s16x4=__attribute__((ext_vector_type(4)))short;
using f32x16=__attribute__((ext_vector_type(16)))float;
using u32x4=__attribute__((ext_vector_type(4)))unsigned;
constexpr int SEQ=8192,D=64,DM=4864;
constexpr int NW=8,QBLK=32,QB=QBLK*NW,KVBLK=64,NQB=SEQ/QB;
__device__ __forceinline__ int crow(int r,int hi){return (r&3)+8*(r>>2)+4*hi;}
#define SBAR() __builtin_amdgcn_sched_barrier(0)
#define ATTN_STORE16(p,v) (*(u32x4*)(p)=(v))
constexpr int NSLOT=3, SLOTB=8192;
constexpr int LDS_K=0, LDS_V=NSLOT*SLOTB, LDS_WS=2*NSLOT*SLOTB, LDS_OST=LDS_WS+NW*64*4, LDS_BYTES=LDS_OST+NW*4096;
constexpr float C2=0.125f*1.4426950408889634f;
__device__ __forceinline__ void glds16(const void*gsrc,unsigned lds_dst){unsigned keep;
  asm volatile("s_mov_b32 %0, m0\n\ts_mov_b32 m0, %2\n\ts_nop 0\n\tglobal_load_lds_dwordx4 %1, off\n\ts_mov_b32 m0, %0":"=&s"(keep):"v"(gsrc),"s"(lds_dst):"memory");}
__device__ __forceinline__ float max3f(float a,float b,float c){float r;asm("v_max3_f32 %0, %1, %2, %3":"=v"(r):"v"(a),"v"(b),"v"(c));return r;}
__device__ __forceinline__ float max2f(float a,float b){float r;asm("v_max_f32_e32 %0, %1, %2":"=v"(r):"v"(a),"v"(b));return r;}
__device__ __forceinline__ float fadd_s(float a,float b){float r;asm("v_add_f32_e32 %0, %1, %2":"=v"(r):"v"(a),"v"(b));return r;}
__device__ __forceinline__ float fsub_s(float a,float b){float r;asm("v_sub_f32_e32 %0, %1, %2":"=v"(r):"v"(a),"v"(b));return r;}
typedef float f32x2_t __attribute__((ext_vector_type(2))); typedef __bf16 bf16x2_t __attribute__((ext_vector_type(2)));
__device__ __forceinline__ unsigned cvtpk_s(float lo,float hi){f32x2_t v={lo,hi};bf16x2_t b=__builtin_convertvector(v,bf16x2_t);return __builtin_bit_cast(unsigned,b);}
#define WAIT_BAR(N) asm volatile("s_waitcnt vmcnt(" #N ") lgkmcnt(0)\n\ts_barrier":::"memory")

__device__ __forceinline__ void qkt(f32x16&p0,f32x16&p1,const char*Kslot,const bf16x8*qr,const f32x16&negm,int r32,int hi){
  const char*kb=Kslot+hi*1024+r32*16;
  #pragma unroll
  for(int d0=0;d0<4;++d0){
    const bf16x8 b0=*reinterpret_cast<const bf16x8*>(kb+d0*2048);
    const bf16x8 b1=*reinterpret_cast<const bf16x8*>(kb+d0*2048+512);
    if(d0==0){p0=__builtin_amdgcn_mfma_f32_32x32x16_bf16(b0,qr[0],negm,0,0,0);p1=__builtin_amdgcn_mfma_f32_32x32x16_bf16(b1,qr[0],negm,0,0,0);}
    else{p0=__builtin_amdgcn_mfma_f32_32x32x16_bf16(b0,qr[d0],p0,0,0,0);p1=__builtin_amdgcn_mfma_f32_32x32x16_bf16(b1,qr[d0],p1,0,0,0);}}
}
typedef __attribute__((address_space(3))) const char* lds_cptr;
typedef short v4i16_t __attribute__((ext_vector_type(4)));
__device__ __forceinline__ void kload8(bf16x8*kf,lds_cptr kp){
  kf[0]=*(const __attribute__((address_space(3))) bf16x8*)(kp);      kf[1]=*(const __attribute__((address_space(3))) bf16x8*)(kp+512);
  kf[2]=*(const __attribute__((address_space(3))) bf16x8*)(kp+2048); kf[3]=*(const __attribute__((address_space(3))) bf16x8*)(kp+2560);
  kf[4]=*(const __attribute__((address_space(3))) bf16x8*)(kp+4096); kf[5]=*(const __attribute__((address_space(3))) bf16x8*)(kp+4608);
  kf[6]=*(const __attribute__((address_space(3))) bf16x8*)(kp+6144); kf[7]=*(const __attribute__((address_space(3))) bf16x8*)(kp+6656);
}
__device__ __forceinline__ void kload2(bf16x8*kf,lds_cptr kp,int j){ kf[2*j]=*(const __attribute__((address_space(3))) bf16x8*)(kp+j*2048); kf[2*j+1]=*(const __attribute__((address_space(3))) bf16x8*)(kp+j*2048+512); }
__device__ __forceinline__ s16x4 vtr(lds_cptr p){ return __builtin_bit_cast(s16x4,__builtin_amdgcn_ds_read_tr16_b64_v4i16((__attribute__((address_space(3))) v4i16_t*)p)); }
__device__ __forceinline__ float rowmax(const f32x16&p0,const f32x16&p1){
  float a=max3f(p0[0],p0[1],p1[0]),b=max3f(p0[2],p0[3],p1[1]);a=max3f(a,p1[2],p1[3]);
  #pragma unroll
  for(int r=4;r<16;r+=4){a=max3f(a,p0[r],p0[r+1]);b=max3f(b,p0[r+2],p0[r+3]);a=max3f(a,p1[r],p1[r+1]);b=max3f(b,p1[r+2],p1[r+3]);}
  const float m=max2f(a,b);
  auto rr=__builtin_amdgcn_permlane32_swap(__float_as_uint(m),__float_as_uint(m),false,false);
  return max2f(__uint_as_float(rr[0]),__uint_as_float(rr[1]));
}
__device__ __forceinline__ void pv(f32x16*o,int vb,bf16x8 pa0,bf16x8 pa1,bf16x8 pa2,bf16x8 pa3){
  #pragma unroll
  for(int d0=0;d0<2;++d0){s16x4 lo[4],hi[4];
    #pragma unroll
    for(int ks=0;ks<4;++ks){
      asm volatile("ds_read_b64_tr_b16 %0,%1 offset:%c2":"=&v"(lo[ks]):"v"(vb),"i"(d0*4096+ks*1024):"memory");
      asm volatile("ds_read_b64_tr_b16 %0,%1 offset:%c2":"=&v"(hi[ks]):"v"(vb),"i"(d0*4096+ks*1024+512):"memory");}
    asm volatile("s_waitcnt lgkmcnt(0)":::"memory");SBAR();
    #define PK(k) (bf16x8){lo[k][0],lo[k][1],lo[k][2],lo[k][3],hi[k][0],hi[k][1],hi[k][2],hi[k][3]}
    o[d0]=__builtin_amdgcn_mfma_f32_32x32x16_bf16(pa0,PK(0),o[d0],0,0,0);
    o[d0]=__builtin_amdgcn_mfma_f32_32x32x16_bf16(pa1,PK(1),o[d0],0,0,0);
    o[d0]=__builtin_amdgcn_mfma_f32_32x32x16_bf16(pa2,PK(2),o[d0],0,0,0);
    o[d0]=__builtin_amdgcn_mfma_f32_32x32x16_bf16(pa3,PK(3),o[d0],0,0,0);
    #undef PK
  }
}
template<int THRL> __device__ __forceinline__ void attn_unit(int qb,const bf16*Qh,const bf16*Kh,const bf16*Vh,bf16*Oh,char*shm,float mbound){
  int tid_=threadIdx.x; asm volatile("":"+v"(tid_));
  const int tid=tid_,lane=tid&63,r32=lane&31,hi=lane>>5; const int wid=__builtin_amdgcn_readfirstlane(tid>>6);
  const int q0=qb*QB;
  if(wid>=4) __builtin_amdgcn_s_setprio(1);
  const bf16*Qw=Qh+(long)(q0+wid*QBLK)*DM;
  const unsigned lds0=(unsigned)(uintptr_t)shm;
  float*wsf=(float*)(shm+LDS_WS)+wid*64;
  const bf16*ksrc=Kh+(long)lane*DM+wid*8;
  const bf16*vsrc=Vh+(long)(16*(wid&3)+(lane>>2))*DM+(wid>>2)*32+(lane&3)*8;
  const unsigned kdst=lds0+LDS_K+wid*1024, vdst=lds0+LDS_V+wid*1024;
  #define DMA_K(t,slot) glds16(ksrc+(long)(t)*KVBLK*DM,(unsigned)__builtin_amdgcn_readfirstlane(kdst+(slot)))
  #define DMA_V(t,slot) glds16(vsrc+(long)(t)*KVBLK*DM,(unsigned)__builtin_amdgcn_readfirstlane(vdst+(slot)))
  const int vb0=(int)(lds0+LDS_V)+((lane>>4)&1)*32+(lane&3)*8+(4*hi+((lane&15)>>2))*64;
  const char*Kbase=shm+LDS_K; bf16x8 kf[8];
  const lds_cptr shm3=(lds_cptr)shm; const lds_cptr kp0=shm3+LDS_K+hi*1024+r32*16; const lds_cptr vp0=shm3+LDS_V+((lane>>4)&1)*32+(lane&3)*8+(4*hi+((lane&15)>>2))*64;
  const int NT=SEQ/KVBLK;
  DMA_K(0,0);DMA_V(0,0);DMA_K(1,SLOTB);
  bf16x8 qr[4];
  #pragma unroll
  for(int d0=0;d0<4;++d0)qr[d0]=*reinterpret_cast<const bf16x8*>(&Qw[(long)r32*DM+d0*16+hi*8]);
  float l_reg=0.f;f32x16 o[2];o[0]=f32x16{};o[1]=f32x16{};f32x16 negm;
  _Pragma("unroll") for(int r=0;r<16;++r)negm[r]=-mbound; asm volatile("":"+v"(negm));
  const int qrel=wid*QBLK+r32;
  #define CMASK(P0,P1,t) do{}while(0)
  bool resc=false;
  #define START(P0,P1) do{ _Pragma("unroll") for(int r=0;r<16;++r)P0[r]=__builtin_amdgcn_exp2f(P0[r]); }while(0)
  #define RESC() do{ if(resc){ asm volatile("s_waitcnt lgkmcnt(0)":::"memory"); \
      _Pragma("unroll") for(int d_=0;d_<2;++d_) _Pragma("unroll") for(int r=0;r<16;++r)o[d_][r]*=wsf[crow(r,hi)]; } }while(0)
  f32x16 pA0,pA1,pB0,pB1;
  int sl_prev=0,sl_cur=0,sl_next=SLOTB;
  #define ROT() do{sl_prev=sl_cur;sl_cur=sl_next;sl_next=(sl_next==(NSLOT-1)*SLOTB)?0:sl_next+SLOTB;}while(0)
  DMA_K(2,2*SLOTB);
  WAIT_BAR(3);
  qkt(pA0,pA1,Kbase,qr,negm,r32,hi);asm volatile("s_nop 15\n\ts_nop 7":"+v"(pA0),"+v"(pA1));CMASK(pA0,pA1,0);
  START(pA0,pA1);
  _Pragma("unroll") for(int r=0;r<16;++r)pA1[r]=__builtin_amdgcn_exp2f(pA1[r]);
  WAIT_BAR(0);
  DMA_K(3,0);DMA_V(1,SLOTB);
  ROT();
  kload8(kf,kp0+sl_cur);
  WAIT_BAR(2);
  s16x4 vlo[8],vhi[8]; u32x4 pw0,pw1,pw2,pw3;
  #define PKW(P,B) cvtpk_s(P[B],P[B+1])
  #define PAF(k) __builtin_bit_cast(bf16x8,pw##k)
  #define VFR(i) (bf16x8){vlo[i][0],vlo[i][1],vlo[i][2],vlo[i][3],vhi[i][0],vhi[i][1],vhi[i][2],vhi[i][3]}
  #define PIN(x) asm volatile("":"+v"(x))
  #define MX3(a,b,c) __builtin_fmaxf(__builtin_fmaxf((a),(b)),(c))
  #define GAPA(MF,A0,A1,A2,A3,W0,W1,PW) do{ MF; sacc+=A0; sacc+=A1; sacc+=A2; sacc+=A3; PIN(sacc); W0; W1; PIN(PW); SBAR(); }while(0)
  #define EX(v) __builtin_amdgcn_exp2f(v)
  #define GAPB(MF,X,B) do{ MF; X[B]=EX(X[B]); X[B+1]=EX(X[B+1]); X[B+2]=EX(X[B+2]); X[B+3]=EX(X[B+3]); PIN(X); SBAR(); }while(0)
  #define VRD(i) do{ vlo[i]=vtr(vp_+(((i)>>2)*4096+((i)&3)*1024)); vhi[i]=vtr(vp_+(((i)>>2)*4096+((i)&3)*1024+512)); }while(0)
  #define KRD(G,j) do{ if(G){ kload2(kf,kp0+sl_next,j); SBAR(); } }while(0)
  #define STEP(C0,C1,P0,P1,t,GK,GV,GL) do{ SBAR(); \
    const lds_cptr vp_=vp0+sl_prev; \
    VRD(0); SBAR(); float sacc=(P0[0]+P0[1]); \
    GAPA(C0=__builtin_amdgcn_mfma_f32_32x32x16_bf16(kf[0],qr[0],negm,0,0,0), P0[2],P0[3],P0[4],P0[5],     pw0[0]=PKW(P0,0), pw0[1]=PKW(P0,2), pw0); \
    VRD(4); SBAR(); GAPA(C1=__builtin_amdgcn_mfma_f32_32x32x16_bf16(kf[1],qr[0],negm,0,0,0), P0[6],P0[7],P0[8],P0[9],     pw0[2]=PKW(P0,4), pw0[3]=PKW(P0,6), pw0); \
    VRD(1); SBAR(); GAPA(C0=__builtin_amdgcn_mfma_f32_32x32x16_bf16(kf[2],qr[1],C0,0,0,0),   P0[10],P0[11],P0[12],P0[13], pw1[0]=PKW(P0,8), pw1[1]=PKW(P0,10), pw1); \
    VRD(5); SBAR(); GAPA(C1=__builtin_amdgcn_mfma_f32_32x32x16_bf16(kf[3],qr[1],C1,0,0,0),   P0[14],P0[15],P1[0],P1[1],   pw1[2]=PKW(P0,12),pw1[3]=PKW(P0,14), pw1); \
    VRD(2); SBAR(); GAPA(C0=__builtin_amdgcn_mfma_f32_32x32x16_bf16(kf[4],qr[2],C0,0,0,0),   P1[2],P1[3],P1[4],P1[5],     pw2[0]=PKW(P1,0), pw2[1]=PKW(P1,2), pw2); \
    VRD(6); SBAR(); GAPA(C1=__builtin_amdgcn_mfma_f32_32x32x16_bf16(kf[5],qr[2],C1,0,0,0),   P1[6],P1[7],P1[8],P1[9],     pw2[2]=PKW(P1,4), pw2[3]=PKW(P1,6), pw2); \
    VRD(3); SBAR(); GAPA(C0=__builtin_amdgcn_mfma_f32_32x32x16_bf16(kf[6],qr[3],C0,0,0,0),   P1[10],P1[11],P1[12],P1[13], pw3[0]=PKW(P1,8), pw3[1]=PKW(P1,10), pw3); \
    VRD(7); SBAR(); GAPA(C1=__builtin_amdgcn_mfma_f32_32x32x16_bf16(kf[7],qr[3],C1,0,0,0),   P1[14],P1[15],0.f,0.f,       pw3[2]=PKW(P1,12),pw3[3]=PKW(P1,14), pw3); \
    l_reg+=sacc; \
    if(GK){DMA_K((t)+3,sl_cur);} if(GV){DMA_V((t)+1,sl_next);} \
    CMASK(C0,C1,t); \
    SBAR(); \
    GAPB(o[0]=__builtin_amdgcn_mfma_f32_32x32x16_bf16(PAF(0),VFR(0),o[0],0,0,0), C0,0); \
    GAPB(o[1]=__builtin_amdgcn_mfma_f32_32x32x16_bf16(PAF(0),VFR(4),o[1],0,0,0), C0,4); \
    KRD(GL,0); GAPB(o[0]=__builtin_amdgcn_mfma_f32_32x32x16_bf16(PAF(1),VFR(1),o[0],0,0,0), C0,8); \
    KRD(GL,1); GAPB(o[1]=__builtin_amdgcn_mfma_f32_32x32x16_bf16(PAF(1),VFR(5),o[1],0,0,0), C0,12); \
    KRD(GL,2); GAPB(o[0]=__builtin_amdgcn_mfma_f32_32x32x16_bf16(PAF(2),VFR(2),o[0],0,0,0), C1,0); \
    KRD(GL,3); GAPB(o[1]=__builtin_amdgcn_mfma_f32_32x32x16_bf16(PAF(2),VFR(6),o[1],0,0,0), C1,4); \
    GAPB(o[0]=__builtin_amdgcn_mfma_f32_32x32x16_bf16(PAF(3),VFR(3),o[0],0,0,0), C1,8); \
    GAPB(o[1]=__builtin_amdgcn_mfma_f32_32x32x16_bf16(PAF(3),VFR(7),o[1],0,0,0), C1,12); \
    }while(0)
  int t=1;
  #undef CMASK
  #define CMASK(P0,P1,t) do{}while(0)
  for(;t+5<NT;t+=2){
    STEP(pB0,pB1,pA0,pA1,t,true,true,true);     WAIT_BAR(2); RESC(); ROT();
    STEP(pA0,pA1,pB0,pB1,t+1,true,true,true);   WAIT_BAR(2); RESC(); ROT();
  }
  #undef CMASK
  #define CMASK(P0,P1,t) do{}while(0)
  #define ENDW(tt) do{ if((tt)+3<NT){WAIT_BAR(2);} else if((tt)+2<NT){WAIT_BAR(1);} else {WAIT_BAR(0);} }while(0)
  for(;t+1<NT;t+=2){
    STEP(pB0,pB1,pA0,pA1,t,(t+3<NT),(t+1<NT),(t+1<NT));       ENDW(t);   RESC(); ROT();
    STEP(pA0,pA1,pB0,pB1,t+1,(t+4<NT),(t+2<NT),(t+2<NT));     ENDW(t+1); RESC(); ROT();
  }
  STEP(pB0,pB1,pA0,pA1,NT-1,false,false,false); RESC();
  { float sacc=pB0[0]+pB0[1]; _Pragma("unroll") for(int r=2;r<16;++r)sacc+=pB0[r]; _Pragma("unroll") for(int r=0;r<16;++r)sacc+=pB1[r]; l_reg+=sacc;
    pw0=(u32x4){PKW(pB0,0),PKW(pB0,2),PKW(pB0,4),PKW(pB0,6)};pw1=(u32x4){PKW(pB0,8),PKW(pB0,10),PKW(pB0,12),PKW(pB0,14)};pw2=(u32x4){PKW(pB1,0),PKW(pB1,2),PKW(pB1,4),PKW(pB1,6)};pw3=(u32x4){PKW(pB1,8),PKW(pB1,10),PKW(pB1,12),PKW(pB1,14)};
    SBAR(); pv(o,vb0+sl_cur,PAF(0),PAF(1),PAF(2),PAF(3)); }
  #undef PKW
  #undef PAF
  #undef VFR
  #undef PIN
  #undef MX3
  #undef GAPA
  #undef GAPB
  #undef EX
  #undef VRD
  #undef KRD
  #undef STEP
  #undef ENDW
  {auto rr=__builtin_amdgcn_permlane32_swap(__float_as_uint(l_reg),__float_as_uint(l_reg),false,false);l_reg=__uint_as_float(rr[0])+__uint_as_float(rr[1]);}
  if(hi==0)wsf[32+r32]=l_reg;asm volatile("s_waitcnt lgkmcnt(0)":::"memory");
  float rli[16];
  #pragma unroll
  for(int r=0;r<16;++r)rli[r]=__builtin_amdgcn_rcpf(wsf[32+crow(r,hi)]);
  bf16*Ow=Oh+(long)(q0+wid*QBLK)*DM;
  { bf16*stg=(bf16*)(shm+LDS_OST)+wid*2048;
    #pragma unroll
    for(int r=0;r<16;++r){const int orow=crow(r,hi);
      #pragma unroll
      for(int d0=0;d0<2;++d0)stg[orow*64+d0*32+r32]=__float2bfloat16(o[d0][r]*rli[r]);}
    asm volatile("s_waitcnt lgkmcnt(0)":::"memory");
    #pragma unroll
    for(int i=0;i<4;++i){const int row=i*8+(lane>>3),ch=lane&7; const u32x4 v=*(const u32x4*)(stg+row*64+ch*8); ATTN_STORE16(Ow+(long)row*DM+ch*8,v);} }
  __builtin_amdgcn_s_setprio(0);
  asm volatile("s_waitcnt lgkmcnt(0)\n\ts_barrier":::"memory");
  #undef DMA_K
  #undef DMA_V
  #undef CMASK
  #undef START
  #undef RESC
  #undef ROT
}
constexpr int ATTN_LDS_BYTES=LDS_BYTES;
#undef SBAR
#undef WAIT_BAR
}
#define GAS __attribute__((address_space(1)))
#define LAS __attribute__((address_space(3)))
typedef unsigned short bf16;
typedef unsigned v4u __attribute__((ext_vector_type(4)));
typedef unsigned v2u __attribute__((ext_vector_type(2)));
typedef float f32x4 __attribute__((ext_vector_type(4)));
typedef float f32x16 __attribute__((ext_vector_type(16)));
typedef short bf16x8 __attribute__((ext_vector_type(8)));
#define LDS_WAIT() asm volatile("s_waitcnt lgkmcnt(0)" ::: "memory")

constexpr int NWAVES = 8, NTHREADS = 512;
constexpr int BATCH = 4, SEQ = 8192, DMODEL = 1024, T = BATCH * SEQ, TH = T / 2, NIN = 8960, NPROJ = 4864, NGATE = 4096, FF = 4096;
constexpr float EPS = 1e-6f, C2 = 0.125f * 1.4426950408889634f, LOG2E = 1.4426950408889634f;
constexpr int C_AQ = 0, C_AK = 512, C_AV = 640, C_BX = 768, C_BY = 1280, C_CQ = 1792, C_CK = 2304, C_CV = 2432, C_DQ = 2560, C_DK = 3328, C_DV = 4096;
constexpr size_t MiB = 1u << 20;
constexpr size_t W_LAYER = 42 * MiB;
constexpr float Q_SW = 127.0f / 0.17f;
constexpr size_t OW_G8 = 10 * MiB;
constexpr int HP = FF + 64;
constexpr size_t OW_IN = 0, OW_PA = 17 * MiB + MiB / 2, OW_PB = OW_PA + MiB, OW_PC = OW_PB + MiB, OW_PD = OW_PC + MiB  , OW_OUT = OW_PD + MiB, OW_1 = OW_OUT + 2 * MiB, OW_G = OW_1 + 8 * MiB, OW_2 = OW_G + MiB / 2;
static_assert(OW_2 + (size_t)1024 * HP * 2 <= W_LAYER, "weight map");
constexpr size_t WS_W = 0, WS_HN = 84 * MiB, WS_PROJ = 148 * MiB, WS_GATES = 300 * MiB, WS_VTC = 364 * MiB, WS_VTD = 368 * MiB, WS_XC = 392 * MiB,
                 WS_LA = 408 * MiB, WS_MG = WS_LA, WS_U = 440 * MiB, WS_LSE = 472 * MiB, WS_SP = WS_LSE + 768 * 1024, WS_CTL = 473 * MiB, WS_RS = WS_CTL + 512 * 1024  , WS_KTC = 474 * MiB, WS_KTD = 478 * MiB, WS_AGG2 = 482 * MiB, WS_CARRY = 490 * MiB, WS_END = 502 * MiB, WS_H = WS_PROJ;
static_assert(WS_H + (size_t)T * HP * 2 <= WS_LA, "H overlay");
constexpr int LDS_BYTES = 147456;
constexpr int NSTEPS = 1 + 2 * (2 * 7 + 1 + 3 + 1);
constexpr int MISC_OFF = 131072 + 320;
constexpr size_t CTL_ZERO_BYTES = 16384 + 32768;
constexpr size_t WS_CM_OFF = 16384;

struct Args { const float* in[20]; float* out; unsigned char* ws; int ph_lo, ph_hi; };
struct Ctx { LAS unsigned char* lds; int tid, lane, wave, vcu, cb, G, gw, NGW; };

__device__ __forceinline__ float wave_sum(float v) {
#pragma unroll
    for (int o = 1; o < 64; o <<= 1) v += __shfl_xor(v, o);
    return v;
}
__device__ __forceinline__ unsigned f2bf(float f) { unsigned u = __builtin_bit_cast(unsigned, f); return (u + 0x7fffu + ((u >> 16) & 1u)) >> 16; }
typedef float f32x2_m __attribute__((ext_vector_type(2))); typedef __bf16 bf16x2_m __attribute__((ext_vector_type(2)));
__device__ __forceinline__ unsigned pk2(float lo, float hi) { const f32x2_m v = {lo, hi}; return __builtin_bit_cast(unsigned, __builtin_convertvector(v, bf16x2_m)); }
__device__ __forceinline__ float bf2f(unsigned short h) { return __uint_as_float((unsigned)h << 16); }
__device__ __forceinline__ float bflo(unsigned w) { return __uint_as_float(w << 16); }
__device__ __forceinline__ float bfhi(unsigned w) { return __uint_as_float(w & 0xffff0000u); }

__device__ __forceinline__ void transpose_item(const float* W, int K, int N, bf16* WT, LAS float* scr, int item, int lane, const float* gk = nullptr, int ldo = 0, int ldw = 0) {
    if (ldo == 0) ldo = K; if (ldw == 0) ldw = N; (void)gk;
    const int nblk = N / 32, kb = item / nblk, nb = item % nblk, k0 = 64 * kb, n0 = 32 * nb;
    float wv[32];
#pragma unroll
    for (int i = 0; i < 32; ++i) wv[i] = W[(size_t)(k0 + 2 * i + (lane >> 5)) * ldw + n0 + (lane & 31)];
#pragma unroll
    for (int i = 0; i < 32; ++i) scr[(2 * i + (lane >> 5)) * 33 + (lane & 31)] = wv[i];
    LDS_WAIT(); asm volatile("" ::: "memory");
    const int c = lane & 7;
#pragma unroll
    for (int j = 0; j < 4; ++j) { const int n = (lane >> 3) + 8 * j; const LAS float* s = scr + (8 * c) * 33 + n;
        v4u o; o.x = pk2(s[0 * 33], s[1 * 33]); o.y = pk2(s[2 * 33], s[3 * 33]); o.z = pk2(s[4 * 33], s[5 * 33]); o.w = pk2(s[6 * 33], s[7 * 33]);
        *(GAS v4u*)(WT + (size_t)(n0 + n) * ldo + k0 + 8 * c) = o; }
    LDS_WAIT(); asm volatile("" ::: "memory");
}
__device__ __forceinline__ unsigned q8(float v) { const int i = (int)rintf(v); return (unsigned)(i < -127 ? -127 : i > 127 ? 127 : i) & 255u; }
__device__ __forceinline__ unsigned pk4_fp8(float a, float b, float c_, float d) { return q8(a) | (q8(b) << 8) | (q8(c_) << 16) | (q8(d) << 24); }
__device__ __forceinline__ void transpose_item_f8(const float* W, int K, int N, int ldw, unsigned char* WT, LAS float* scr, int item, int lane, float scale, const unsigned* cm = nullptr) {
    const int nblk = N / 32, kb = item / nblk, nb = item % nblk, k0 = 64 * kb, n0 = 32 * nb;
    if (cm) scale = 127.0f / fmaxf(__uint_as_float(cm[n0 + (lane & 31)]), 1e-30f);
    float wv[32];
#pragma unroll
    for (int i = 0; i < 32; ++i) wv[i] = W[(size_t)(k0 + 2 * i + (lane >> 5)) * ldw + n0 + (lane & 31)];
#pragma unroll
    for (int i = 0; i < 32; ++i) scr[(2 * i + (lane >> 5)) * 33 + (lane & 31)] = wv[i] * scale;
    LDS_WAIT(); asm volatile("" ::: "memory");
    const int cc = lane & 7;
#pragma unroll
    for (int j = 0; j < 4; ++j) { const int n = (lane >> 3) + 8 * j; const LAS float* s = scr + (8 * cc) * 33 + n;
        v2u o; o.x = pk4_fp8(s[0 * 33], s[1 * 33], s[2 * 33], s[3 * 33]); o.y = pk4_fp8(s[4 * 33], s[5 * 33], s[6 * 33], s[7 * 33]);
        *(v2u*)(WT + (size_t)(n0 + n) * K + k0 + 8 * cc) = o; }
    LDS_WAIT(); asm volatile("" ::: "memory");
}
__device__ __forceinline__ void p0_prologue(const Ctx& c, const Args& a) {
    LAS float* scr = (LAS float*)(c.lds + c.wave * 16384);
    constexpr int I_IN = 16 * 128 + 16 * 128 + 16 * 24,     I_P = 8 * 32, I_PD = 4 * 32, I_O = 16 * 32, I_1 = 16 * 128, I_2 = 64 * 32, I_L = I_IN + 3 * I_P + I_PD + I_O + I_2;
    for (int it = c.gw; it < 2 * I_L; it += c.NGW) {
        const int l = it / I_L; int r = it % I_L; unsigned char* wl = a.ws + WS_W + (size_t)l * W_LAYER;
        if (r < 16 * 128) { transpose_item(a.in[2] + (size_t)l * 1024 * NIN, 1024, C_DV, (bf16*)(wl + OW_IN), scr, r, c.lane, nullptr, 0, NIN); continue; } r -= 16 * 128;
        if (r < 16 * 128) { transpose_item_f8(a.in[2] + (size_t)l * 1024 * NIN + NPROJ, 1024, NGATE, NIN, wl + OW_G8, scr, r, c.lane, Q_SW); continue; } r -= 16 * 128;
        if (r < 16 * 24) { transpose_item_f8(a.in[2] + (size_t)l * 1024 * NIN + C_DV, 1024, 768, NIN, wl + OW_G8 + (size_t)NGATE * 1024, scr, r, c.lane, Q_SW); continue; } r -= 16 * 24;
        if (r < I_P) { transpose_item(a.in[11] + (size_t)l * 512 * 1024, 512, 1024, (bf16*)(wl + OW_PA), scr, r, c.lane); continue; } r -= I_P;
        if (r < I_P) { transpose_item(a.in[12] + (size_t)l * 512 * 1024, 512, 1024, (bf16*)(wl + OW_PB), scr, r, c.lane); continue; } r -= I_P;
        if (r < I_P) { transpose_item(a.in[13] + (size_t)l * 512 * 1024, 512, 1024, (bf16*)(wl + OW_PC), scr, r, c.lane); continue; } r -= I_P;
        if (r < I_PD) { transpose_item(a.in[14] + (size_t)l * 256 * 1024, 256, 1024, (bf16*)(wl + OW_PD), scr, r, c.lane, nullptr, 512); continue; } r -= I_PD;
        if (r < I_O) { transpose_item(a.in[15] + (size_t)l * 1024 * 1024, 1024, 1024, (bf16*)(wl + OW_OUT), scr, r, c.lane); continue; } r -= I_O;
        transpose_item(a.in[18] + (size_t)l * FF * 1024, FF, 1024, (bf16*)(wl + OW_2), scr, r, c.lane, nullptr, HP);
    }
    for (int idx = c.vcu * NTHREADS + c.tid; idx < 2 * 8 * FF; idx += c.G * NTHREADS) { const int l = idx / (8 * FF), seg = (idx / FF) & 7, n = idx % FF;
        const float* wp = a.in[17] + ((size_t)l * 1024 + seg * 128) * FF + n; float mx = 0.f;
#pragma unroll 16
        for (int i = 0; i < 128; ++i) mx = fmaxf(mx, fabsf(wp[(size_t)i * FF]));
        atomicMax((unsigned*)(a.ws + WS_CTL + WS_CM_OFF) + l * FF + n, __float_as_uint(mx)); }
    for (int idx = c.vcu * NTHREADS + c.tid; idx < 2048; idx += c.G * NTHREADS) ((float*)(a.ws + WS_SP))[idx] = 8.0f * log1pf(__expf(-a.in[9][idx]));
    const int gt = c.vcu * NTHREADS + c.tid, GT = c.G * NTHREADS;
    for (int idx = gt; idx < 2 * 2048 * 16; idx += GT) {
        const int l = idx / (2048 * 16), n = (idx >> 4) & 2047, k0 = (idx & 15) * 8;
        const int cl = n & 127, g = (n >> 7) & 1, cb = (n >> 8) & 3, d = n >> 10, nb = cb * 2 + (cl >> 6), dd = cl & 63;
        v4u o = (v4u){0u, 0u, 0u, 0u};
        if ((k0 >> 6) == (cl >> 6)) { const float* gw = a.in[7] + ((((size_t)(l * 2 + d) * 2 + g) * 8 + nb) * 64 + (k0 & 63)) * 64 + dd;
            o.x = pk2(gw[0], gw[64]); o.y = pk2(gw[128], gw[192]); o.z = pk2(gw[256], gw[320]); o.w = pk2(gw[384], gw[448]); }
        *(v4u*)((bf16*)(a.ws + WS_W + (size_t)l * W_LAYER + OW_G) + (size_t)n * 128 + k0) = o;
    }
}
__device__ __forceinline__ void convert_w1_i8(const Ctx& c, const Args& a) {
    LAS float* scr = (LAS float*)(c.lds + c.wave * 16384);
    for (int it = c.gw; it < 2 * 2048; it += c.NGW) { const int l = it / 2048, r = it % 2048;
        transpose_item_f8(a.in[17] + (size_t)l * 1024 * FF, 1024, FF, FF, a.ws + WS_W + (size_t)l * W_LAYER + OW_1, scr, r, c.lane, 0.f, (const unsigned*)(a.ws + WS_CTL + WS_CM_OFF) + l * FF); }
}
__device__ __forceinline__ float wave_max(float v) {
#pragma unroll
    for (int o = 1; o < 64; o <<= 1) v = fmaxf(v, __shfl_xor(v, o));
    return v;
}
__device__ __forceinline__ void rms_rows_bf16(const Ctx& c, const float* x, const float* g, bf16* o, int nrows, unsigned char* o8, float* rs) {
    f32x4 gv[4];
#pragma unroll
    for (int j = 0; j < 4; ++j) gv[j] = ((const f32x4*)g)[c.lane + 64 * j];
    for (int m = c.gw; m < nrows; m += 2 * c.NGW) {
        const f32x4* xa = (const f32x4*)(x + (size_t)m * DMODEL) + c.lane; const f32x4* xb = (const f32x4*)(x + (size_t)(m + c.NGW) * DMODEL) + c.lane; f32x4 va[4], vb[4]; float sa = 0.f, sb = 0.f;
#pragma unroll
        for (int j = 0; j < 4; ++j) { va[j] = xa[64 * j]; vb[j] = xb[64 * j]; }
#pragma unroll
        for (int j = 0; j < 4; ++j) { sa += (va[j].x * va[j].x + va[j].y * va[j].y) + (va[j].z * va[j].z + va[j].w * va[j].w); sb += (vb[j].x * vb[j].x + vb[j].y * vb[j].y) + (vb[j].z * vb[j].z + vb[j].w * vb[j].w); }
        const float ra = rsqrtf(wave_sum(sa) * (1.f / DMODEL) + EPS), rb = rsqrtf(wave_sum(sb) * (1.f / DMODEL) + EPS);
        v2u* oa = (v2u*)(o + (size_t)m * DMODEL) + c.lane; v2u* ob = (v2u*)(o + (size_t)(m + c.NGW) * DMODEL) + c.lane;
#pragma unroll
        for (int j = 0; j < 4; ++j) { v2u w; w.x = pk2(va[j].x * ra * gv[j].x, va[j].y * ra * gv[j].y); w.y = pk2(va[j].z * ra * gv[j].z, va[j].w * ra * gv[j].w); oa[64 * j] = w;
            w.x = pk2(vb[j].x * rb * gv[j].x, vb[j].y * rb * gv[j].y); w.y = pk2(vb[j].z * rb * gv[j].z, vb[j].w * rb * gv[j].w); ob[64 * j] = w; }
        float ma = 0.f, mb = 0.f;
#pragma unroll
        for (int j = 0; j < 4; ++j) { va[j] = va[j] * ra * gv[j]; vb[j] = vb[j] * rb * gv[j];
            ma = fmaxf(fmaxf(ma, fmaxf(fabsf(va[j].x), fabsf(va[j].y))), fmaxf(fabsf(va[j].z), fabsf(va[j].w))); mb = fmaxf(fmaxf(mb, fmaxf(fabsf(vb[j].x), fabsf(vb[j].y))), fmaxf(fabsf(vb[j].z), fabsf(vb[j].w))); }
        ma = fmaxf(wave_max(ma), 1e-20f); mb = fmaxf(wave_max(mb), 1e-20f);
        const float qa = 127.f / ma, qb = 127.f / mb; if (c.lane == 0) { rs[m] = ma * (1.f / 127.f); rs[m + c.NGW] = mb * (1.f / 127.f); }
#pragma unroll
        for (int j = 0; j < 4; ++j) { ((unsigned*)(o8 + (size_t)m * DMODEL))[c.lane + 64 * j] = pk4_fp8(va[j].x * qa, va[j].y * qa, va[j].z * qa, va[j].w * qa);
            ((unsigned*)(o8 + (size_t)(m + c.NGW) * DMODEL))[c.lane + 64 * j] = pk4_fp8(vb[j].x * qb, vb[j].y * qb, vb[j].z * qb, vb[j].w * qb); }
    }
}
__device__ __forceinline__ void rms_rows_b2b(const Ctx& c, const bf16* x, const float* g, bf16* o, int nrows, unsigned char* o8 = nullptr, float* rs = nullptr) {
    f32x4 gv[4];
#pragma unroll
    for (int j = 0; j < 4; ++j) gv[j] = ((const f32x4*)g)[c.lane * 4 + j];
    for (int m = c.gw; m < nrows; m += 4 * c.NGW) { v4u w[4][2]; float s[4];
#pragma unroll
        for (int r = 0; r < 4; ++r) { const v4u* xr = (const v4u*)(x + (size_t)(m + r * c.NGW) * DMODEL) + c.lane * 2; w[r][0] = xr[0]; w[r][1] = xr[1]; }
#pragma unroll
        for (int r = 0; r < 4; ++r) { float q = 0.f;
#pragma unroll
            for (int h = 0; h < 2; ++h) { const v4u t = w[r][h]; q += (bflo(t.x) * bflo(t.x) + bfhi(t.x) * bfhi(t.x)) + (bflo(t.y) * bflo(t.y) + bfhi(t.y) * bfhi(t.y)) + (bflo(t.z) * bflo(t.z) + bfhi(t.z) * bfhi(t.z)) + (bflo(t.w) * bflo(t.w) + bfhi(t.w) * bfhi(t.w)); }
            s[r] = q; }
#pragma unroll
        for (int r = 0; r < 4; ++r) { const float rr = rsqrtf(wave_sum(s[r]) * (1.f / DMODEL) + EPS); v4u* orow = (v4u*)(o + (size_t)(m + r * c.NGW) * DMODEL) + c.lane * 2;
#pragma unroll
            for (int h = 0; h < 2; ++h) { const v4u t = w[r][h]; const f32x4 ga = gv[2 * h], gb = gv[2 * h + 1]; v4u ov;
                ov.x = pk2(bflo(t.x) * rr * ga.x, bfhi(t.x) * rr * ga.y); ov.y = pk2(bflo(t.y) * rr * ga.z, bfhi(t.y) * rr * ga.w);
                ov.z = pk2(bflo(t.z) * rr * gb.x, bfhi(t.z) * rr * gb.y); ov.w = pk2(bflo(t.w) * rr * gb.z, bfhi(t.w) * rr * gb.w); if (o) orow[h] = ov; }
            if (o8) { float mx = 0.f;
#pragma unroll
                for (int h = 0; h < 2; ++h) { const v4u t = w[r][h]; const f32x4 ga = gv[2 * h], gb = gv[2 * h + 1];
                    mx = fmaxf(mx, fmaxf(fmaxf(fabsf(bflo(t.x) * ga.x), fabsf(bfhi(t.x) * ga.y)), fmaxf(fabsf(bflo(t.y) * ga.z), fabsf(bfhi(t.y) * ga.w))));
                    mx = fmaxf(mx, fmaxf(fmaxf(fabsf(bflo(t.z) * gb.x), fabsf(bfhi(t.z) * gb.y)), fmaxf(fabsf(bflo(t.w) * gb.z), fabsf(bfhi(t.w) * gb.w)))); }
                mx = fmaxf(wave_max(mx) * rr, 1e-20f); const float r16 = rr * (127.f / mx); if (c.lane == 0) rs[m + r * c.NGW] = mx * (1.f / 127.f);
#pragma unroll
                for (int h = 0; h < 2; ++h) { const v4u t = w[r][h]; const f32x4 ga = gv[2 * h], gb = gv[2 * h + 1]; v2u o;
                    o.x = pk4_fp8(bflo(t.x) * r16 * ga.x, bfhi(t.x) * r16 * ga.y, bflo(t.y) * r16 * ga.z, bfhi(t.y) * r16 * ga.w);
                    o.y = pk4_fp8(bflo(t.z) * r16 * gb.x, bfhi(t.z) * r16 * gb.y, bflo(t.w) * r16 * gb.z, bfhi(t.w) * r16 * gb.w);
                    *(v2u*)(o8 + (size_t)(m + r * c.NGW) * DMODEL + c.lane * 16 + h * 8) = o; } } }
    }
}
__device__ __forceinline__ void rms_final_b2f(const Ctx& c, const bf16* x, const float* g, float* o, int nrows) {
    f32x4 gv[4];
#pragma unroll
    for (int j = 0; j < 4; ++j) gv[j] = ((const f32x4*)g)[c.lane * 4 + j];
    for (int m = c.gw; m < nrows; m += 4 * c.NGW) { v4u w[4][2]; float s[4];
#pragma unroll
        for (int r = 0; r < 4; ++r) { const v4u* xr = (const v4u*)(x + (size_t)(m + r * c.NGW) * DMODEL) + c.lane * 2; w[r][0] = xr[0]; w[r][1] = xr[1]; }
#pragma unroll
        for (int r = 0; r < 4; ++r) { float q = 0.f;
#pragma unroll
            for (int h = 0; h < 2; ++h) { const v4u t = w[r][h]; q += (bflo(t.x) * bflo(t.x) + bfhi(t.x) * bfhi(t.x)) + (bflo(t.y) * bflo(t.y) + bfhi(t.y) * bfhi(t.y)) + (bflo(t.z) * bflo(t.z) + bfhi(t.z) * bfhi(t.z)) + (bflo(t.w) * bflo(t.w) + bfhi(t.w) * bfhi(t.w)); }
            s[r] = q; }
#pragma unroll
        for (int r = 0; r < 4; ++r) { const float rr = rsqrtf(wave_sum(s[r]) * (1.f / DMODEL) + EPS); f32x4* orow = (f32x4*)(o + (size_t)(m + r * c.NGW) * DMODEL) + c.lane * 4;
#pragma unroll
            for (int h = 0; h < 2; ++h) { const v4u t = w[r][h]; const f32x4 ga = gv[2 * h], gb = gv[2 * h + 1];
                orow[2 * h] = (f32x4){bflo(t.x) * rr * ga.x, bfhi(t.x) * rr * ga.y, bflo(t.y) * rr * ga.z, bfhi(t.y) * rr * ga.w};
                orow[2 * h + 1] = (f32x4){bflo(t.z) * rr * gb.x, bfhi(t.z) * rr * gb.y, bflo(t.w) * rr * gb.z, bfhi(t.w) * rr * gb.w}; } }
    }
}
__device__ __forceinline__ void sincos_rr(float ang, float& s, float& co) {
    const float n = rintf(ang * 0.15915494309189535f);
    float r = fmaf(-n, 6.28125f, ang); r = fmaf(-n, 1.9353071795864769e-3f, r);
    s = __sinf(r); co = __cosf(r);
}
__device__ __forceinline__ void rot8f(float (&x)[8], const float* cs, const float* sn, int xm, float scale) {
#pragma unroll
    for (int e = 0; e < 8; ++e) { const float xp = __shfl_xor(x[e], xm); x[e] = (x[e] * cs[e] + sn[e] * xp) * scale; }
}
template <bool DUMMY> __device__ __forceinline__ void rot8(v4u& w, const float* cs, const float* sn, int xm, float scale) {
    const v4u w0_ = w;
    float x[8] = {bflo(w.x), bfhi(w.x), bflo(w.y), bfhi(w.y), bflo(w.z), bfhi(w.z), bflo(w.w), bfhi(w.w)};
    rot8f(x, cs, sn, xm, scale);
    w.x = pk2(x[0], x[1]); w.y = pk2(x[2], x[3]); w.z = pk2(x[4], x[5]); w.w = pk2(x[6], x[7]);
    if (DUMMY) { asm volatile("" :: "v"(w.x), "v"(w.y), "v"(w.z), "v"(w.w)); w = w0_; }
}
template <bool DUMMY = false> __device__ __forceinline__ void p3_prep(const Ctx& c, bf16* PROJ, bf16* XC, bf16* VTC, bf16* VTD, bf16* KTC, bf16* KTD, const float* qkg, const float* convw, const float* convb) {
    const int lane = c.lane, l8 = lane & 7, t8 = lane >> 3;
    const float L2T = 13.287712379549449f;
    for (int grp = c.gw; grp < TH / 8; grp += c.NGW) {
        const int tl = grp * 8 + t8, s = tl & (SEQ - 1);
        float cs1[8], sn1[8], csa[8], sna[8], gq[8], gk[8];
#pragma unroll
        for (int e = 0; e < 8; ++e) { const int i = l8 * 8 + e; float sv, cv;
            sincos_rr((float)s * __builtin_amdgcn_exp2f(-(float)(2 * (i & 31)) * (1.f / 64.f) * L2T), sv, cv); cs1[e] = cv; sn1[e] = (i & 32) ? sv : -sv;
            sincos_rr((float)((i & 32) ? (s & 63) : (s >> 6)) * __builtin_amdgcn_exp2f(-(float)(2 * (i & 15)) * (1.f / 32.f) * L2T), sv, cv); csa[e] = cv; sna[e] = (i & 16) ? sv : -sv;
            gq[e] = qkg[i]; gk[e] = qkg[64 + i]; }
        bf16* row = PROJ + (size_t)tl * NPROJ + l8 * 8;
#pragma unroll 10
        for (int h = 0; h < 10; ++h) { v4u w = *(const v4u*)(row + h * 64); const v4u w0_ = w;
            float x[8] = {bflo(w.x), bfhi(w.x), bflo(w.y), bfhi(w.y), bflo(w.z), bfhi(w.z), bflo(w.w), bfhi(w.w)}; float q = 0.f;
#pragma unroll
            for (int e = 0; e < 8; ++e) q += x[e] * x[e];
            q += __shfl_xor(q, 1); q += __shfl_xor(q, 2); q += __shfl_xor(q, 4);
            const float r = rsqrtf(q * (1.f / 64.f) + EPS);
#pragma unroll
            for (int e = 0; e < 8; ++e) x[e] *= r * (h < 8 ? gq[e] : gk[e]);
            rot8f(x, csa, sna, 2, h < 8 ? C2 : 1.f);
            w.x = pk2(x[0], x[1]); w.y = pk2(x[2], x[3]); w.z = pk2(x[4], x[5]); w.w = pk2(x[6], x[7]); if (DUMMY) { asm volatile("" :: "v"(w.x), "v"(w.y), "v"(w.z), "v"(w.w)); w = w0_; } *(v4u*)(row + h * 64) = w; }
#pragma unroll 10
        for (int h = 0; h < 10; ++h) { v4u w = *(const v4u*)(row + C_CQ + h * 64); rot8<DUMMY>(w, cs1, sn1, 4, h < 8 ? C2 : 1.f);
            if (h < 8) *(v4u*)(row + C_CQ + h * 64) = w;
            else *(v4u*)(KTC + ((size_t)(((tl >> 13) * 2 + (h - 8)) * 256 + (s >> 5)) * 2048) + (l8 * 32 + (s & 31)) * 8) = w; }
#pragma unroll 12
        for (int h = 0; h < 24; ++h) { v4u w = *(const v4u*)(row + C_DQ + h * 64); rot8<DUMMY>(w, cs1, sn1, 4, h < 12 ? C2 : 1.f);
            if (h < 12) *(v4u*)(row + C_DQ + h * 64) = w;
            else { const int gh = h - 12, sh = 2 * (gh >> 2), P = (s & ((1 << sh) - 1)) * (SEQ >> sh) + (s >> sh);
                *(v4u*)(KTD + ((size_t)(((tl >> 13) * 12 + gh) * 256 + (P >> 5)) * 2048) + (l8 * 32 + (P & 31)) * 8) = w; } }
    }
    { float cw[4][8], cb[8];
#pragma unroll
      for (int e = 0; e < 8; ++e) { cb[e] = convb[8 * lane + e];
#pragma unroll
          for (int j = 0; j < 4; ++j) cw[j][e] = convw[j * 512 + 8 * lane + e]; }
      for (int grp = c.gw; grp < TH / 8; grp += c.NGW) { const int tl0 = grp * 8, s0 = tl0 & (SEQ - 1);
          v4u xr[11];
#pragma unroll
          for (int j = 0; j < 11; ++j) { const int sp = s0 - 2 + j; xr[j] = (sp >= 0 && sp < SEQ) ? *(const v4u*)(PROJ + (size_t)(tl0 - 2 + j) * NPROJ + C_BX + 8 * lane) : (v4u){0u, 0u, 0u, 0u}; }
#pragma unroll
          for (int t = 0; t < 8; ++t) { float acc[8];
#pragma unroll
              for (int e = 0; e < 8; ++e) acc[e] = cb[e];
#pragma unroll
              for (int j = 0; j < 4; ++j) { const v4u xw = xr[t + j];
                  acc[0] += bflo(xw.x) * cw[j][0]; acc[1] += bfhi(xw.x) * cw[j][1]; acc[2] += bflo(xw.y) * cw[j][2]; acc[3] += bfhi(xw.y) * cw[j][3];
                  acc[4] += bflo(xw.z) * cw[j][4]; acc[5] += bfhi(xw.z) * cw[j][5]; acc[6] += bflo(xw.w) * cw[j][6]; acc[7] += bfhi(xw.w) * cw[j][7]; }
              v4u o; o.x = pk2(acc[0], acc[1]); o.y = pk2(acc[2], acc[3]); o.z = pk2(acc[4], acc[5]); o.w = pk2(acc[6], acc[7]);
              *(v4u*)(XC + (size_t)(tl0 + t) * 512 + 8 * lane) = o; } } }
    LAS bf16* scr = (LAS bf16*)(c.lds + c.wave * 16384);
    for (int it = c.gw; it < 2 * 14 * 128; it += c.NGW) {
        const int ch = it & 127, vh = (it >> 7) % 14, b = it / (14 * 128), s0 = ch * 64;
        const bf16* src = PROJ + (size_t)(b * SEQ + s0) * NPROJ + (vh < 2 ? C_CV + vh * 64 : C_DV + (vh - 2) * 64);
#pragma unroll
        for (int i = 0; i < 8; ++i) { const int r = i * 8 + (lane >> 3), cc = lane & 7; *(LAS v4u*)(scr + r * 72 + cc * 8) = *(const v4u*)(src + (size_t)r * NPROJ + cc * 8); }
        LDS_WAIT(); asm volatile("" ::: "memory");
        const int sh = vh < 2 ? 0 : 2 * ((vh - 2) >> 2), L = SEQ >> sh;
        bf16* dst = vh < 2 ? VTC + (size_t)(b * 2 + vh) * 256 * 2048 : VTD + (size_t)(b * 12 + (vh - 2)) * 256 * 2048;
        const int d = lane;
#pragma unroll 4
        for (int gq = 0; gq < 16; ++gq) { const int r = gq >> (4 - sh), q = gq & ((16 >> sh) - 1);
            const int P = r * L + (s0 >> sh) + 4 * q, kk = P & 31, mh = (kk >> 4) & 1, j = (kk >> 3) & 1, hi = (kk >> 2) & 1;
            const int t0 = ((4 * q) << sh) + r, ts = 1 << sh;
            v2u o; o.x = (unsigned)scr[t0 * 72 + d] | ((unsigned)scr[(t0 + ts) * 72 + d] << 16); o.y = (unsigned)scr[(t0 + 2 * ts) * 72 + d] | ((unsigned)scr[(t0 + 3 * ts) * 72 + d] << 16);
            *(v2u*)(dst + (size_t)(P >> 5) * 2048 + ((((d >> 5) * 2 + mh) * 2 + hi) * 32 + (d & 31)) * 8 + 4 * j) = o; }
        LDS_WAIT(); asm volatile("" ::: "memory");
    }
}
__device__ __forceinline__ int crow(int r, int hi) { return (r & 3) + 8 * (r >> 2) + 4 * hi; }
template <bool SINK, int NT, int PD>
__device__ __forceinline__ void banded_item(const bf16* Q, long qstride, const bf16* KT, const bf16* VT, bf16* O, long ostride, float* lse, long lsestride,
                                            int L, int q0, float sink2, int lane) {
    constexpr int hw = (NT - 1) * 16;
    const int r32 = lane & 31, hi = lane >> 5, qq = q0 + r32;
    int t_lo = (hw - q0) / 32; if (t_lo < 0) t_lo = 0;
    int t_hi = (L - q0 + hw) / 32; if (t_hi > NT) t_hi = NT;
    const long tb = (long)((q0 - hw) / 32);
    const bf16* kp = KT + tb * 2048 + (hi * 32 + r32) * 8;
    const bf16* vp = VT + tb * 2048 + (hi * 32 + r32) * 8;
    bf16x8 qf[4], kf[PD][4], vf[PD][4];
#pragma unroll
    for (int d0 = 0; d0 < 4; ++d0) qf[d0] = *(const bf16x8*)(Q + (long)qq * qstride + d0 * 16 + hi * 8);
#pragma unroll
    for (int t = 0; t < PD; ++t) if (t >= t_lo && t < t_hi) {
#pragma unroll
        for (int i = 0; i < 4; ++i) { kf[t][i] = *(const bf16x8*)(kp + (long)t * 2048 + i * 512); vf[t][i] = *(const bf16x8*)(vp + (long)t * 2048 + i * 512); } }
    float mhat = SINK ? sink2 : -1e30f, l = 0.f; f32x16 o0 = {}, o1 = {};
#pragma unroll
    for (int kt = 0; kt < NT; ++kt) { constexpr int dummy_ = 0; (void)dummy_; const int sl = kt % PD;
        if (kt >= t_lo && kt < t_hi) { const int k0 = q0 - hw + 32 * kt;
            f32x16 sacc = {};
#pragma unroll
            for (int d0 = 0; d0 < 4; ++d0) sacc = __builtin_amdgcn_mfma_f32_32x32x16_bf16(kf[sl][d0], qf[d0], sacc, 0, 0, 0);
            const bool interior = (32 * kt - hw + 31 <= hw) && (32 * kt - hw - 31 >= -hw);
            float rm = -1e30f; unsigned vmask = interior ? 0xffffu : 0u;
#pragma unroll
            for (int r = 0; r < 16; ++r) { if (interior) { rm = fmaxf(rm, sacc[r]); } else { const int dk = k0 + crow(r, hi) - qq; const bool ok = (dk <= hw && dk >= -hw); vmask |= ok ? (1u << r) : 0u; rm = fmaxf(rm, ok ? sacc[r] : -1e30f); } }
            rm = fmaxf(rm, __shfl_xor(rm, 32));
            if (__any(rm > mhat + 8.f)) { const float mn = fmaxf(mhat, rm), f = __builtin_amdgcn_exp2f(mhat - mn); mhat = mn; l *= f;
#pragma unroll
                for (int r = 0; r < 16; ++r) { const float fr = __shfl(f, crow(r, hi)); o0[r] *= fr; o1[r] *= fr; } }
            float p[16];
#pragma unroll
            for (int r = 0; r < 16; ++r) { p[r] = ((vmask >> r) & 1u) ? __builtin_amdgcn_exp2f(sacc[r] - mhat) : 0.f; l += p[r]; }
            v4u pa0, pa1; pa0.x = pk2(p[0], p[1]); pa0.y = pk2(p[2], p[3]); pa0.z = pk2(p[4], p[5]); pa0.w = pk2(p[6], p[7]);
            pa1.x = pk2(p[8], p[9]); pa1.y = pk2(p[10], p[11]); pa1.z = pk2(p[12], p[13]); pa1.w = pk2(p[14], p[15]);
            const bf16x8 a0 = __builtin_bit_cast(bf16x8, pa0), a1 = __builtin_bit_cast(bf16x8, pa1);
            o0 = __builtin_amdgcn_mfma_f32_32x32x16_bf16(a0, vf[sl][0], o0, 0, 0, 0); o0 = __builtin_amdgcn_mfma_f32_32x32x16_bf16(a1, vf[sl][1], o0, 0, 0, 0);
            o1 = __builtin_amdgcn_mfma_f32_32x32x16_bf16(a0, vf[sl][2], o1, 0, 0, 0); o1 = __builtin_amdgcn_mfma_f32_32x32x16_bf16(a1, vf[sl][3], o1, 0, 0, 0); }
        if (kt + PD < NT) { const int tn = kt + PD; if (tn >= t_lo && tn < t_hi) {
#pragma unroll
            for (int i = 0; i < 4; ++i) { kf[sl][i] = *(const bf16x8*)(kp + (long)tn * 2048 + i * 512); vf[sl][i] = *(const bf16x8*)(vp + (long)tn * 2048 + i * 512); } } } }
    l += __shfl_xor(l, 32); if (SINK) l += __builtin_amdgcn_exp2f(sink2 - mhat);
    const float rl = __builtin_amdgcn_rcpf(l);
#pragma unroll
    for (int r = 0; r < 16; ++r) { const int qr = crow(r, hi); const float f = __shfl(rl, qr);
        bf16* op = O + (long)(q0 + qr) * ostride + r32; const unsigned w = pk2(o0[r] * f, o1[r] * f); op[0] = (bf16)(w & 0xffffu); op[32] = (bf16)(w >> 16); }
    if (lse && hi == 0) lse[(long)qq * lsestride] = mhat + __builtin_amdgcn_logf(l);
}
__device__ __forceinline__ void p4_banded(const Ctx& c, bf16* PROJ, const bf16* VTC, const bf16* VTD, const bf16* KTC, const bf16* KTD, float* LSE, const float* sink, bool dummy = false) {
    constexpr int NC = 2 * 2 * 256 * 4, ND = 2 * 3 * 1024;
    for (int it = c.gw; it < NC + ND; it += c.NGW) {
        if (it < NC) { const int hq = it & 3, ti = (it >> 2) & 255, kvh = (it >> 10) & 1, b = it >> 11, h = kvh * 4 + hq;
            bf16* Q = PROJ + (size_t)b * SEQ * NPROJ + C_CQ + h * 64; const size_t to = (size_t)(b * 2 + kvh) * 256 * 2048;
            banded_item<true, 9, 3>(Q, NPROJ, KTC + to, VTC + to, dummy ? Q - C_CQ + C_BX : Q, NPROJ, nullptr, 0, SEQ, ti * 32, sink[h] * LOG2E, c.lane);
        } else { const int r = it - NC; const int b = r / 3072, g = (r / 1024) % 3, w = r & 1023, h = w >> 8, v = w & 255;
            const int sh = 2 * g, dil = 1 << sh, L = SEQ >> sh, tpr = L / 32, res = v / tpr, ti = v % tpr, gh = g * 4 + h;
            bf16* Q = PROJ + ((size_t)b * SEQ + res) * NPROJ + C_DQ + gh * 64; const size_t to = ((size_t)(b * 12 + gh) * 256 + (size_t)res * tpr) * 2048;
            banded_item<false, 5, 4>(Q, (long)dil * NPROJ, KTD + to, VTD + to, dummy ? Q - C_DQ + C_DV : Q, (long)dil * NPROJ,
                               LSE + ((size_t)b * SEQ + res) * 12 + gh, (long)dil * 12, L, ti * 32, 0.f, c.lane); }
    }
}
constexpr int SCH = 16, NCH = SEQ / SCH;
__device__ __forceinline__ void p5_scan1_combine(const Ctx& c, const bf16* LA, const bf16* U, float* AGG, const bf16* PROJ, const float* LSE, bf16* YD) {
    for (int it = c.vcu * 4 + (c.tid >> 7); it < 2 * NCH; it += c.G * 4) { const int b = it / NCH, j = it % NCH, c4 = (c.tid & 127) * 4;
#pragma unroll
        for (int dir = 0; dir < 2; ++dir) { const size_t ro = ((size_t)dir * TH + b * SEQ + j * SCH) * 512 + c4;
            v2u lw[SCH], uw[SCH];
#pragma unroll
            for (int p = 0; p < SCH; ++p) { lw[p] = *(const v2u*)(LA + ro + (size_t)p * 512); uw[p] = *(const v2u*)(U + ro + (size_t)p * 512); }
            float h[4] = {0.f, 0.f, 0.f, 0.f}, sa[4] = {0.f, 0.f, 0.f, 0.f};
#pragma unroll
            for (int i = 0; i < SCH; ++i) { const int p = dir ? SCH - 1 - i : i;
                const float l0 = bflo(lw[p].x), l1 = bfhi(lw[p].x), l2 = bflo(lw[p].y), l3 = bfhi(lw[p].y);
                h[0] = __builtin_amdgcn_exp2f(l0) * h[0] + bflo(uw[p].x); h[1] = __builtin_amdgcn_exp2f(l1) * h[1] + bfhi(uw[p].x);
                h[2] = __builtin_amdgcn_exp2f(l2) * h[2] + bflo(uw[p].y); h[3] = __builtin_amdgcn_exp2f(l3) * h[3] + bfhi(uw[p].y);
                sa[0] += l0; sa[1] += l1; sa[2] += l2; sa[3] += l3; }
            const int q = dir ? NCH - 1 - j : j;
#pragma unroll
            for (int e = 0; e < 4; ++e) { float2 v; v.x = sa[e]; v.y = h[e]; ((float2*)AGG)[((size_t)(b * 2 + dir) * 512 + c4 + e) * NCH + q] = v; } } }
    for (int tl = c.gw; tl < TH; tl += c.NGW) { const int h = c.lane >> 4, d4 = (c.lane & 15) * 4;
        const float l0 = LSE[(size_t)tl * 12 + h], l1 = LSE[(size_t)tl * 12 + 4 + h], l2 = LSE[(size_t)tl * 12 + 8 + h];
        const float mx = fmaxf(l0, fmaxf(l1, l2)); float w0 = __builtin_amdgcn_exp2f(l0 - mx), w1 = __builtin_amdgcn_exp2f(l1 - mx), w2 = __builtin_amdgcn_exp2f(l2 - mx);
        const float inv = __builtin_amdgcn_rcpf(w0 + w1 + w2); w0 *= inv; w1 *= inv; w2 *= inv;
        const bf16* pr = PROJ + (size_t)tl * NPROJ + C_DQ + h * 64 + d4;
        const v2u a = *(const v2u*)pr, bq = *(const v2u*)(pr + 256), cq = *(const v2u*)(pr + 512);
        v2u o; o.x = pk2(w0 * bflo(a.x) + w1 * bflo(bq.x) + w2 * bflo(cq.x), w0 * bfhi(a.x) + w1 * bfhi(bq.x) + w2 * bfhi(cq.x));
        o.y = pk2(w0 * bflo(a.y) + w1 * bflo(bq.y) + w2 * bflo(cq.y), w0 * bfhi(a.y) + w1 * bfhi(bq.y) + w2 * bfhi(cq.y));
        *(v2u*)(YD + (size_t)tl * NPROJ + C_DK + h * 64 + d4) = o; }
}
__device__ __forceinline__ float gelu_tanh(float x) { const float z = 0.7978845608028654f * (x + 0.044715f * x * x * x); const float e = __builtin_amdgcn_exp2f(2.f * LOG2E * z); return 0.5f * x * (2.f - 2.f * __builtin_amdgcn_rcpf(1.f + e)); }
__device__ __forceinline__ void p5b_carry(const Ctx& c, const float* AGG, float* CARRY) {
    for (int w = c.gw; w < 2 * 2 * 512; w += c.NGW) { const float2* ag = (const float2*)AGG + (size_t)w * NCH + c.lane * 8;
        float2 v[8];
#pragma unroll
        for (int i = 0; i < 8; ++i) v[i] = ag[i];
        float A = 0.f, H = 0.f;
#pragma unroll
        for (int i = 0; i < 8; ++i) { H = __builtin_amdgcn_exp2f(v[i].x) * H + v[i].y; A += v[i].x; }
#pragma unroll
        for (int d = 1; d < 64; d <<= 1) { const float Ap = __shfl_up(A, d), Hp = __shfl_up(H, d); if (c.lane >= d) { H = __builtin_amdgcn_exp2f(A) * Hp + H; A += Ap; } }
        float cin = __shfl_up(H, 1); if (c.lane == 0) cin = 0.f;
        float* co = CARRY + (size_t)w * NCH + c.lane * 8; f32x4 o0, o1;
        o0.x = cin; cin = __builtin_amdgcn_exp2f(v[0].x) * cin + v[0].y; o0.y = cin; cin = __builtin_amdgcn_exp2f(v[1].x) * cin + v[1].y; o0.z = cin; cin = __builtin_amdgcn_exp2f(v[2].x) * cin + v[2].y; o0.w = cin; cin = __builtin_amdgcn_exp2f(v[3].x) * cin + v[3].y;
        o1.x = cin; cin = __builtin_amdgcn_exp2f(v[4].x) * cin + v[4].y; o1.y = cin; cin = __builtin_amdgcn_exp2f(v[5].x) * cin + v[5].y; o1.z = cin; cin = __builtin_amdgcn_exp2f(v[6].x) * cin + v[6].y; o1.w = cin;
        *(f32x4*)co = o0; *(f32x4*)(co + 4) = o1; }
}
__device__ __forceinline__ void p6_scan3(const Ctx& c, const bf16* LA, const bf16* U, const float* CARRY, const bf16* PROJ, bf16* YB) {
    for (int it = c.vcu * 4 + (c.tid >> 7); it < 2 * NCH; it += c.G * 4) { const int b = it / NCH, j = it % NCH, c4 = (c.tid & 127) * 4;
        const size_t r0 = (size_t)b * SEQ + j * SCH;
        float hf[4], hb[4];
#pragma unroll
        for (int e = 0; e < 4; ++e) { hf[e] = CARRY[((size_t)(b * 2 + 0) * 512 + c4 + e) * NCH + j]; hb[e] = CARRY[((size_t)(b * 2 + 1) * 512 + c4 + e) * NCH + (NCH - 1 - j)]; }
        v2u lw[SCH], uw[SCH]; float hs[SCH][4];
#pragma unroll
        for (int p = 0; p < SCH; ++p) { lw[p] = *(const v2u*)(LA + (r0 + p) * 512 + c4); uw[p] = *(const v2u*)(U + (r0 + p) * 512 + c4); }
#pragma unroll
        for (int p = 0; p < SCH; ++p) {
            hf[0] = __builtin_amdgcn_exp2f(bflo(lw[p].x)) * hf[0] + bflo(uw[p].x); hf[1] = __builtin_amdgcn_exp2f(bfhi(lw[p].x)) * hf[1] + bfhi(uw[p].x);
            hf[2] = __builtin_amdgcn_exp2f(bflo(lw[p].y)) * hf[2] + bflo(uw[p].y); hf[3] = __builtin_amdgcn_exp2f(bfhi(lw[p].y)) * hf[3] + bfhi(uw[p].y);
            hs[p][0] = hf[0]; hs[p][1] = hf[1]; hs[p][2] = hf[2]; hs[p][3] = hf[3]; }
#pragma unroll
        for (int p = 0; p < SCH; ++p) { lw[p] = *(const v2u*)(LA + ((size_t)TH + r0 + p) * 512 + c4); uw[p] = *(const v2u*)(U + ((size_t)TH + r0 + p) * 512 + c4); }
        v2u yw[SCH];
#pragma unroll
        for (int p = 0; p < SCH; ++p) yw[p] = *(const v2u*)(PROJ + (r0 + p) * NPROJ + C_BY + c4);
#pragma unroll
        for (int p = SCH - 1; p >= 0; --p) {
            hb[0] = __builtin_amdgcn_exp2f(bflo(lw[p].x)) * hb[0] + bflo(uw[p].x); hb[1] = __builtin_amdgcn_exp2f(bfhi(lw[p].x)) * hb[1] + bfhi(uw[p].x);
            hb[2] = __builtin_amdgcn_exp2f(bflo(lw[p].y)) * hb[2] + bflo(uw[p].y); hb[3] = __builtin_amdgcn_exp2f(bfhi(lw[p].y)) * hb[3] + bfhi(uw[p].y);
            v2u o; o.x = pk2((hs[p][0] + hb[0]) * gelu_tanh(bflo(yw[p].x)), (hs[p][1] + hb[1]) * gelu_tanh(bfhi(yw[p].x)));
            o.y = pk2((hs[p][2] + hb[2]) * gelu_tanh(bflo(yw[p].y)), (hs[p][3] + hb[3]) * gelu_tanh(bfhi(yw[p].y)));
            *(v2u*)(YB + (r0 + p) * NPROJ + C_BX + c4) = o; }
    }
}
typedef __attribute__((address_space(1))) unsigned gu32;
#define RLX_AGENT __ATOMIC_RELAXED, __HIP_MEMORY_SCOPE_AGENT
#define XB_TMO      128
#define XB_XCNT(j)  (256  + 64 * (j))
#define XB_XSUB(j)  (1280 + 64 * (j))
#define XB_XGEN(j)  (2304 + 64 * (j))
#define XB_TOP      3328
#define XB_TOPGEN   3392
#define XCD_BAR_WORDS 3456
#define XB_SPIN_CAP (1u << 18)

__device__ __forceinline__ unsigned xb_ld(unsigned* p)              { return __hip_atomic_load(p, __ATOMIC_RELAXED, __HIP_MEMORY_SCOPE_AGENT); }
__device__ __forceinline__ unsigned xb_add(unsigned* p, unsigned v) { return __hip_atomic_fetch_add(p, v, __ATOMIC_RELAXED, __HIP_MEMORY_SCOPE_AGENT); }
__device__ __forceinline__ unsigned xb_xcc_id() { return (unsigned)__builtin_amdgcn_s_getreg((3 << 11) | 20) & 0xFu; }
#define XB_SPIN(cond, bar) do { unsigned _sp = 0; while (cond) { __builtin_amdgcn_s_sleep(1); \
    if ((++_sp & 255u) == 0u) { if (xb_ld(&(bar)[XB_TMO])) break; if (_sp > XB_SPIN_CAP) { atomicAdd(&(bar)[XB_TMO], 1u); break; } } } } while (0)

struct XcdBarrier {
    unsigned* bar; unsigned x;
    volatile LAS unsigned* st;
};

__device__ __forceinline__ XcdBarrier xcd_barrier_post(unsigned* bar, volatile LAS unsigned* st) {
    XcdBarrier b; b.bar = bar; b.x = xb_xcc_id(); b.st = st;
    if (threadIdx.x == 0) (void)xb_add(&bar[XB_XCNT(b.x)], 1u);
    return b;
}
__device__ __forceinline__ void xcd_barrier_complete(unsigned* bar, unsigned x, unsigned& nloc, unsigned& nx) {
    const unsigned G = gridDim.x * gridDim.y * gridDim.z;
    unsigned sum, cnt, mine, sp = 0u;
    for (;;) {
        sum = 0u; cnt = 0u; mine = 0u;
#pragma unroll
        for (unsigned j = 0; j < 16; ++j) { const unsigned c = xb_ld(&bar[XB_XCNT(j)]); sum += c; cnt += (c > 0u) ? 1u : 0u; mine = (j == x) ? c : mine; }
        if (sum == G) break;
        __builtin_amdgcn_s_sleep(1);
        if ((++sp & 255u) == 0u) { if (xb_ld(&bar[XB_TMO])) break; if (sp > XB_SPIN_CAP) { atomicAdd(&bar[XB_TMO], 1u); break; } }
    }
    nloc = mine > 0u ? mine : 1u; nx = cnt > 0u ? cnt : 1u;
}

__device__ __forceinline__ void xcd_barrier(const XcdBarrier& b) {
    asm volatile("s_waitcnt vmcnt(0)" ::: "memory");
    __syncthreads();
    if (threadIdx.x == 0) {
        unsigned* bar = b.bar;
        __builtin_amdgcn_s_waitcnt(0);
        unsigned nloc = b.st[0], nx = b.st[1];
        if (nloc == 0u) { xcd_barrier_complete(bar, b.x, nloc, nx); b.st[0] = nloc; b.st[1] = nx; }
        const unsigned old = xb_add(&bar[XB_XSUB(b.x)], 1u);
        const unsigned gen = old / nloc;
        if (old + 1u == (gen + 1u) * nloc) {
            __builtin_amdgcn_fence(__ATOMIC_RELEASE, "agent");
            asm volatile("s_waitcnt vmcnt(0)" ::: "memory");
            const unsigned og = xb_add(&bar[XB_TOP], 1u);
            const unsigned tg = og / nx;
            if (og + 1u == (tg + 1u) * nx) xb_add(&bar[XB_TOPGEN], 1u);
            else XB_SPIN(xb_ld(&bar[XB_TOPGEN]) == tg, bar);
            __builtin_amdgcn_fence(__ATOMIC_ACQUIRE, "agent");
            xb_add(&bar[XB_XGEN(b.x)], 1u);
            asm volatile("s_waitcnt vmcnt(0)" ::: "memory");
        } else {
            XB_SPIN(xb_ld(&bar[XB_XGEN(b.x)]) == gen, bar);
            __builtin_amdgcn_fence(__ATOMIC_ACQUIRE, "agent");
            asm volatile("s_waitcnt vmcnt(0)" ::: "memory");
        }
    }
    __syncthreads();
}
__device__ __forceinline__ void p6_attn(const Ctx& c, bf16* PROJ, char* shm, const float* qkg, int ocol = C_AQ) {
    const float mbound = wave_max(fabsf(qkg[c.lane])) * wave_max(fabsf(qkg[64 + c.lane])) * (64.0f * C2 * 1.02f);
    for (int i = 0;; ++i) { int uidx; if (c.G == 256) { if (i >= 2) break; uidx = c.vcu * 2 + i; } else { uidx = c.vcu + i * c.G; if (uidx >= 512) break; }
        const int bk = uidx >> 7, rem = uidx & 127, hq = rem >> 5, qb = rem & 31, b = bk >> 1, kvh = bk & 1, h = kvh * 4 + hq;
        bf16* base = PROJ + (size_t)b * SEQ * NPROJ;
        attn_body::attn_unit<8>(qb, (const attn_body::bf16*)(base + C_AQ + h * 64), (const attn_body::bf16*)(base + C_AK + kvh * 64), (const attn_body::bf16*)(base + C_AV + kvh * 64),
                                (attn_body::bf16*)(base + ocol + h * 64), shm, mbound); }
}
__global__ void __launch_bounds__(NTHREADS, 2) fwd(Args a) {
    extern __shared__ __attribute__((aligned(16))) unsigned char lds[];
    cg::grid_group grid = cg::this_grid();
    const Args& aa = a;
    for (int u = threadIdx.x; u < (LDS_BYTES - 131072) / 4; u += NTHREADS) ((LAS unsigned*)((LAS unsigned char*)lds + 131072))[u] = 0u;
    __syncthreads();
    XcdBarrier bar = xcd_barrier_post((unsigned*)(a.ws + WS_CTL), (volatile LAS unsigned*)((LAS unsigned char*)lds + MISC_OFF) + 8);
#define MISCW ((volatile LAS unsigned*)((LAS unsigned char*)lds + MISC_OFF))
    if (threadIdx.x == 0) { const unsigned xcc = xb_xcc_id(); MISCW[16] = xb_add((unsigned*)(a.ws + WS_CTL) + 3584 + 32 * xcc, 1u); MISCW[17] = xcc; MISCW[18] = blockIdx.x; }
    __syncthreads();
#define MKCTX() Ctx c; { int t_ = threadIdx.x; asm volatile("" : "+v"(t_)); c.lds = (LAS unsigned char*)lds; c.tid = t_; c.lane = t_ & 63; c.wave = __builtin_amdgcn_readfirstlane(t_ >> 6); \
        { int g_ = gridDim.x; asm volatile("" : "+s"(g_)); c.G = g_; } c.vcu = __builtin_amdgcn_readfirstlane((int)MISCW[18]); c.cb = (c.G % 8 == 0) ? (c.vcu % (c.G / 8)) * 8 + c.vcu / (c.G / 8) : c.vcu; c.gw = c.vcu * NWAVES + c.wave; c.NGW = c.G * NWAVES; } \
    unsigned char* ws = aa.ws; asm volatile("" : "+s"(ws)); const unsigned char* wl = ws + WS_W + (size_t)l * W_LAYER; const float* xin = l == 0 ? aa.in[0] : aa.out; const size_t r0 = (size_t)hb * TH; (void)wl; (void)xin; (void)r0;
#define HN ((bf16*)(ws + WS_HN))
#define PROJ ((bf16*)(ws + WS_PROJ))
#define GATES (ws + WS_GATES)
#define VTC ((bf16*)(ws + WS_VTC))
#define VTD ((bf16*)(ws + WS_VTD))
#define XC ((bf16*)(ws + WS_XC))
#define YB PROJ
#define LA ((bf16*)(ws + WS_LA))
#define MG (HN + r0 * DMODEL)
#define U ((bf16*)(ws + WS_U))
#define LSE ((float*)(ws + WS_LSE))
#define AGG ((float*)(ws + WS_AGG2))
#define CARRY ((float*)(ws + WS_CARRY))
#define YD PROJ
#define KTC ((bf16*)(ws + WS_KTC))
#define KTD ((bf16*)(ws + WS_KTD))
#define HB ((bf16*)(ws + WS_H))
#define XB ((bf16*)((unsigned char*)aa.out + 64 * MiB))
#define HN8 ((unsigned char*)aa.out)
#define RS ((float*)(ws + WS_RS))
#define XF ((bf16*)(ws + WS_LA))
    int l = 0, hb = 0;
    int step = 0;
#ifndef ENMASK
#define ENMASK 0xFFFF
#endif
#define EN(k) ((ENMASK >> (k)) & 1)
#ifndef NSYNC
#define NSYNC 1
#endif
#ifndef REPMASK
#define REPMASK 0
#endif
#define REP(k) (1 + ((REPMASK >> (k)) & 1))
#define PHASE(...) do { if (step >= a.ph_lo && step < a.ph_hi) { { MKCTX(); __VA_ARGS__; } if (step + 1 < a.ph_hi) { if (step == 0) { if (a.ph_lo < 0) grid.sync();     \
            xcd_barrier(bar); \
            if (threadIdx.x == 0) { unsigned pre = 0u; const unsigned xcc = MISCW[17]; for (unsigned j = 0; j < 16; ++j) { const unsigned cj = xb_ld((unsigned*)(a.ws + WS_CTL) + 3584 + 32 * j); pre += j < xcc ? cj : 0u; } MISCW[18] = pre + MISCW[16]; } \
            __syncthreads(); } else { for (int s_ = 0; s_ < NSYNC; ++s_) xcd_barrier(bar); } } } ++step; } while (0)
#define GEMM(EPI, g, E) do { pg8::StaticOrder S_; S_.init((g).M, (g).N, c.G, c.cb); pg8::gemm_phase<EPI, pg8::StaticOrder, true, true>(c.lds, g, S_, E); } while (0)
    PHASE({ for (int rp_ = 0; rp_ < REP(0); ++rp_) p0_prologue(c, a); rms_rows_bf16(c, a.in[0], a.in[1], HN, T, HN8, RS); });
    for (l = 0; l < 2; ++l) {
        for (hb = 0; hb < 2; ++hb) {
            PHASE({ { pg8::Gemm g{HN + r0 * DMODEL, (const bf16*)(wl + OW_IN), TH, C_DV, DMODEL, DMODEL, DMODEL}; pg8::EpiProj E{PROJ}; GEMM(pg8::EpiProj, g, E); }
                    { int k8_ = DMODEL / 2; asm volatile("" : "+s"(k8_));     pg8::Gemm g{(const bf16*)(HN8 + r0 * DMODEL), (const bf16*)(wl + OW_G8), TH, NGATE + 768, k8_, DMODEL / 2, DMODEL / 2}; pg8::EpiGate E{GATES, a.in[3] + l * NGATE, RS + r0, 1.0f / Q_SW, PROJ};
                      pg8::StaticOrder S_; S_.init(g.M, g.N, c.G, c.cb); pg8::gemm_phase<pg8::EpiGate, pg8::StaticOrder, true, true, true>(c.lds, g, S_, E); } });
            PHASE({ if (REP(12) > 1) p3_prep<true>(c, PROJ, XC, VTC, VTD, KTC, KTD, a.in[4] + l * 128, a.in[5] + l * 2048, a.in[6] + l * 512); p3_prep<false>(c, PROJ, XC, VTC, VTD, KTC, KTD, a.in[4] + l * 128, a.in[5] + l * 2048, a.in[6] + l * 512); if (l == 0 && hb == 0) { __syncthreads(); convert_w1_i8(c, a); } });
            PHASE(if (EN(4)) { int kq_ = 128; asm volatile("" : "+s"(kq_));
                    pg8::Gemm g{XC, (const bf16*)(wl + OW_G), TH, 2048, kq_, 512, 128}; pg8::EpiLru E{XC, LA, U, a.in[8] + l * 2048, (const float*)(ws + WS_SP) + l * 1024, TH}; for (int rp_ = 0; rp_ < REP(4); ++rp_) { pg8::LruOrder S_; S_.init(g.M, g.N, c.G, c.cb); pg8::gemm_phase<pg8::EpiLru, pg8::LruOrder, true, true>(c.lds, g, S_, E); }
                    if (REP(3) > 1) p4_banded(c, PROJ, VTC, VTD, KTC, KTD, LSE, a.in[10] + l * 8, true); p4_banded(c, PROJ, VTC, VTD, KTC, KTD, LSE, a.in[10] + l * 8); });
            PHASE(for (int rp_ = 0; rp_ < REP(5); ++rp_) p5_scan1_combine(c, LA, U, AGG, PROJ, LSE, YD));
            PHASE(p5b_carry(c, AGG, CARRY));
            PHASE({ for (int rp_ = 0; rp_ < REP(6); ++rp_) p6_scan3(c, LA, U, CARRY, PROJ, YB); __syncthreads(); if (REP(7) > 1) p6_attn(c, PROJ, (char*)lds, a.in[4] + l * 128, C_BX); p6_attn(c, PROJ, (char*)lds, a.in[4] + l * 128); });
            PHASE(for (int rp_ = 0; rp_ < REP(8); ++rp_) { pg8::Gemm g{PROJ, (const bf16*)(wl + OW_PA), TH, DMODEL, 512, NPROJ, 512}; pg8::EpiBranch E{GATES, MG};
                    pg8::BranchOrder S_; S_.init(g.M, g.N, c.G, c.cb); S_.a0 = C_AQ * 2; S_.a1 = C_BX * 2; S_.a2 = C_CQ * 2; S_.a3 = C_DK * 2;
                    S_.b1 = (unsigned)(OW_PB - OW_PA); S_.b2 = (unsigned)(OW_PC - OW_PA); S_.b3 = (unsigned)(OW_PD - OW_PA);
                    pg8::gemm_phase<pg8::EpiBranch, pg8::BranchOrder, true, true>(c.lds, g, S_, E); });
        }
        hb = 0;
        PHASE({ pg8::Gemm g{HN, (const bf16*)(wl + OW_OUT), T, DMODEL, DMODEL, DMODEL, DMODEL}; pg8::EpiResidB E{l == 0 ? (const void*)a.in[0] : (const void*)XB, XB, l == 0 ? 1 : 0}; GEMM(pg8::EpiResidB, g, E); });
        PHASE(rms_rows_b2b(c, XB, a.in[16] + l * DMODEL, nullptr, T, HN8, RS));
        PHASE({ int k8_ = DMODEL / 2; asm volatile("" : "+s"(k8_)); pg8::Gemm g{(const bf16*)HN8, (const bf16*)(wl + OW_1), T, FF, k8_, DMODEL / 2, DMODEL / 2}; pg8::EpiRelu2I8 E{HB, HP, RS, (const unsigned*)(ws + WS_CTL + WS_CM_OFF) + l * FF};
                pg8::StaticOrder S_; S_.init(g.M, g.N, c.G, c.cb); pg8::gemm_phase<pg8::EpiRelu2I8, pg8::StaticOrder, true, true, true>(c.lds, g, S_, E); });
        PHASE({ pg8::Gemm g{HB, (const bf16*)(wl + OW_2), T, DMODEL, FF, HP, HP}; pg8::EpiResidB E{(const void*)XB, l == 0 ? XB : XF, 0}; GEMM(pg8::EpiResidB, g, E); });
        PHASE({ if (l == 0) rms_rows_b2b(c, XB, a.in[1] + DMODEL, HN, T, HN8, RS); else rms_final_b2f(c, XF, a.in[19], a.out, T); });
    }
#undef PHASE
#undef GEMM
}

extern "C" void kernel_launch(void* const* d_in, const int* in_sizes, int n_in, void* d_out, int out_size, void* d_ws, size_t ws_size, hipStream_t stream) {
    static int grid = 0;
    if (grid == 0) {
        if (n_in != 20 || out_size != T * DMODEL || ws_size < WS_END) { fprintf(stderr, "kernel_launch: unexpected shapes (n_in %d out %d ws %zu)\n", n_in, out_size, ws_size); grid = -1; return; }
        int dev = 0, cus = 0, per_cu = 0;
        if (hipGetDevice(&dev) != hipSuccess || hipDeviceGetAttribute(&cus, hipDeviceAttributeMultiprocessorCount, dev) != hipSuccess) { grid = -1; return; }
        if (hipFuncSetAttribute((const void*)fwd, hipFuncAttributeMaxDynamicSharedMemorySize, LDS_BYTES) != hipSuccess) { fprintf(stderr, "hipFuncSetAttribute failed\n"); grid = -1; return; }
        if (hipOccupancyMaxActiveBlocksPerMultiprocessor(&per_cu, (const void*)fwd, NTHREADS, LDS_BYTES) != hipSuccess || per_cu < 1) per_cu = 1;
        if (per_cu > 1) per_cu = 1;
        (void)hipGetLastError();
        grid = cus * per_cu;
        fprintf(stderr, "kernel_launch: grid %d (cus %d x %d) ws %zu\n", grid, cus, per_cu, ws_size);
    }
    if (grid < 0) return;
    if (hipMemsetAsync((char*)d_ws + WS_CTL, 0, CTL_ZERO_BYTES, stream) != hipSuccess) { fprintf(stderr, "kernel_launch: memset failed\n"); return; }
    Args a{};
    for (int i = 0; i < 20; ++i) a.in[i] = (const float*)d_in[i];
    a.out = (float*)d_out; a.ws = (unsigned char*)d_ws;
#if defined(MK_MULTI) && MK_MULTI
    for (int s = 0; s < NSTEPS; ++s) { a.ph_lo = s; a.ph_hi = s + 1; hipLaunchKernelGGL(fwd, dim3(grid), dim3(NTHREADS), LDS_BYTES, stream, a); }
#else
    a.ph_lo = 0; a.ph_hi = NSTEPS;
    void* args[] = {&a};
    const hipError_t e = hipLaunchCooperativeKernel((const void*)fwd, dim3(grid), dim3(NTHREADS), args, LDS_BYTES, stream);
    if (e != hipSuccess) fprintf(stderr, "kernel_launch: cooperative launch failed: %s (grid %d)\n", hipGetErrorString(e), grid);
#endif
}
```
